# Optimizing an MI355X kernel written in HIP

```python
import math, functools
import jax
import jax.numpy as jnp
from jax import lax
import numpy as np

D_MODEL = 1024
BATCH = 32
SEQ = 256
DEPTH = 2
DEC_BATCH = 8
DEC_SEQ = 4096
PAST_LEN = 256

GRID_W = 64
D_MIX = D_MODEL
HEAD_DIM = 64
D_SSD = D_MIX // 2
SSD_HEADS = D_SSD // HEAD_DIM
SSD_STATE = 64
SSD_GROUPS = 2
SSD_BC = SSD_GROUPS * SSD_STATE
SSD_CHUNK = 128
D_RWKV = D_MIX // 4
RWKV_HEADS = D_RWKV // HEAD_DIM
LORA_W = 32
LORA_A = 32
LORA_G = 64
D_MLSTM = D_MIX // 4
MLSTM_HEADS = D_MLSTM // HEAD_DIM
MLSTM_CHUNK = 128
CONV_W = 3
D_FF = ((8 * D_MODEL + 3 * 256 - 1) // (3 * 256)) * 256
SSD_COLS = 2 * D_SSD + 2 * SSD_BC + 2 * SSD_HEADS
RWKV_COLS = 3 * D_RWKV + 2 * LORA_W + 2 * LORA_A + LORA_G
MLSTM_COLS = 4 * D_MLSTM + 4 * MLSTM_HEADS
D_IN = SSD_COLS + RWKV_COLS + MLSTM_COLS

kernel_name = 'hybrid_ssd_rwkv7_mlstm_diffusion_step'


def _split(u, sizes):
    return jnp.split(u, np.cumsum(sizes)[:-1].tolist(), axis=-1)


def _flip(z):
    return jnp.flip(z, axis=1)


def _rms_norm(x, g, eps=1e-6):
    xf = x.astype(jnp.float32)
    y = xf * lax.rsqrt(jnp.mean(xf * xf, axis=-1, keepdims=True) + eps)
    return (y * g.astype(jnp.float32)).astype(x.dtype)


def _group_norm(y, g, n_groups, center, eps=1e-5):
    shp = y.shape
    yf = y.astype(jnp.float32).reshape(shp[:-1] + (n_groups, shp[-1] // n_groups))
    if center:
        yf = yf - jnp.mean(yf, axis=-1, keepdims=True)
    yf = yf * lax.rsqrt(jnp.mean(yf * yf, axis=-1, keepdims=True) + eps)
    return (yf.reshape(shp) * g.astype(jnp.float32)).astype(y.dtype)


def _dwconv_centred(u, w, b):
    k = w.shape[0]
    out = lax.conv_general_dilated(u, w[:, None, :].astype(u.dtype), window_strides=(1,),
                                   padding=[(k // 2, k // 2)], dimension_numbers=('NWC', 'WIO', 'NWC'),
                                   feature_group_count=u.shape[-1])
    return out + b


def _seq_shift(u):
    b, t, c = u.shape
    g = u.reshape(b, t, c // 2, 2)
    prev = jnp.pad(g[:, :-1, :, 0], ((0, 0), (1, 0), (0, 0)))
    nxt = jnp.pad(g[:, 1:, :, 1], ((0, 0), (0, 1), (0, 0)))
    return jnp.stack([prev, nxt], axis=-1).reshape(b, t, c)


def _grid_shift(u, grid_w):
    b, t, c = u.shape
    rows = t // grid_w
    g = u.reshape(b, rows, grid_w, c // 4, 4)
    left = jnp.pad(g[:, :, :-1, :, 0], ((0, 0), (0, 0), (1, 0), (0, 0)))
    right = jnp.pad(g[:, :, 1:, :, 1], ((0, 0), (0, 0), (0, 1), (0, 0)))
    up = jnp.pad(g[:, :-1, :, :, 2], ((0, 0), (1, 0), (0, 0), (0, 0)))
    down = jnp.pad(g[:, 1:, :, :, 3], ((0, 0), (0, 1), (0, 0), (0, 0)))
    return jnp.stack([left, right, up, down], axis=-1).reshape(b, t, c)


def _bidir(scan_fn, seqs, s0, reverse):
    if reverse:
        y, s = scan_fn(*[_flip(z) for z in seqs], s0)
        return _flip(y), s
    return scan_fn(*seqs, s0)


def _ssd_scan(a, x, dt, bh, ch, s0):
    f32 = jnp.float32
    b, t, nh, p = x.shape
    n = bh.shape[-1]
    L = SSD_CHUNK
    nc = t // L
    la = (dt * a).astype(f32).reshape(b, nc, L, nh)
    xd = (x * dt[..., None]).astype(f32).reshape(b, nc, L, nh, p)
    br = bh.astype(f32).reshape(b, nc, L, nh, n)
    cr = ch.astype(f32).reshape(b, nc, L, nh, n)
    acum = jnp.cumsum(la, axis=2)
    causal = jnp.tril(jnp.ones((L, L), bool))
    seg = acum[:, :, :, None, :] - acum[:, :, None, :, :]
    decay = jnp.exp(jnp.where(causal[None, None, :, :, None], seg, -jnp.inf))
    scores = jnp.einsum('bcthn,bcshn->bctsh', cr, br) * decay
    y = jnp.einsum('bctsh,bcshp->bcthp', scores, xd)
    to_end = jnp.exp(acum[:, :, -1:, :] - acum)
    chunk_states = jnp.einsum('bcsh,bcshn,bcshp->bchpn', to_end, br, xd)
    chunk_decay = jnp.exp(acum[:, :, -1, :])

    def step(s, inp):
        cs, cd = inp
        return s * cd[:, :, None, None] + cs, s

    s_fin, s_start = lax.scan(step, s0.astype(f32),
                              (jnp.moveaxis(chunk_states, 1, 0), jnp.moveaxis(chunk_decay, 1, 0)))
    s_start = jnp.moveaxis(s_start, 0, 1)
    y = y + jnp.einsum('bcthn,bchpn->bcthp', cr, s_start) * jnp.exp(acum)[..., None]
    return y.reshape(b, t, nh, p).astype(x.dtype), s_fin.astype(x.dtype)


def _rwkv7_scan(r, w, k, v, kk, a, s0):
    f32 = jnp.float32
    xs = tuple(jnp.moveaxis(z.astype(f32), 1, 0) for z in (r, w, k, v, kk, a))

    def step(S, inp):
        r_t, w_t, k_t, v_t, kk_t, a_t = inp
        sa = jnp.einsum('bhij,bhj->bhi', S, kk_t)
        S = (S * w_t[:, :, None, :] - sa[..., None] * (kk_t * a_t)[:, :, None, :]
             + v_t[..., None] * k_t[:, :, None, :])
        return S, jnp.einsum('bhij,bhj->bhi', S, r_t)

    s_fin, ys = lax.scan(step, s0.astype(f32), xs)
    return jnp.moveaxis(ys, 0, 1).astype(r.dtype), s_fin.astype(r.dtype)


def _mlstm_chunked(q, k, v, ig, lf, state):
    f32 = jnp.float32
    b, t, nh, dh = q.shape
    L = MLSTM_CHUNK
    nc = t // L
    causal = jnp.tril(jnp.ones((L, L), bool))

    def chunks(z):
        z = z.astype(f32)
        return jnp.moveaxis(z.reshape((b, nc, L) + z.shape[2:]), 1, 0)

    def step(carry, inp):
        c_st, n_st, m_st = carry
        qc, kc, vc, ic, fc = inp
        bcum = jnp.cumsum(fc, axis=1)
        dmat = jnp.where(causal[None, :, :, None],
                         bcum[:, :, None, :] - bcum[:, None, :, :] + ic[:, None, :, :], -jnp.inf)
        inter = bcum + m_st[:, None, :]
        m_t = jnp.maximum(inter, jnp.max(dmat, axis=2))
        wts = jnp.exp(dmat - m_t[:, :, None, :]) * jnp.einsum('bthd,bshd->btsh', qc, kc)
        w_carry = jnp.exp(inter - m_t)
        num = (jnp.einsum('btsh,bshd->bthd', wts, vc)
               + w_carry[..., None] * jnp.einsum('bhij,bthj->bthi', c_st, qc))
        den = jnp.sum(wts, axis=2) + w_carry * jnp.einsum('bhj,bthj->bth', n_st, qc)
        h_t = num / jnp.maximum(jnp.abs(den), jnp.exp(-m_t))[..., None]
        m_new = m_t[:, -1]
        w_end = jnp.exp(bcum[:, -1:] - bcum + ic - m_new[:, None])
        carry_decay = jnp.exp(bcum[:, -1] + m_st - m_new)
        c_new = carry_decay[..., None, None] * c_st + jnp.einsum('bsh,bshi,bshj->bhij', w_end, vc, kc)
        n_new = carry_decay[..., None] * n_st + jnp.einsum('bsh,bshj->bhj', w_end, kc)
        return (c_new, n_new, m_new), h_t

    init = tuple(s.astype(f32) for s in state)
    (c_fin, n_fin, m_fin), hs = lax.scan(step, init, tuple(chunks(z) for z in (q, k, v, ig, lf)))
    h_out = jnp.moveaxis(hs, 0, 1).reshape(b, t, nh, dh).astype(q.dtype)
    return h_out, (c_fin.astype(q.dtype), n_fin.astype(q.dtype), m_fin.astype(q.dtype))


def _ssd_mixer(u, conv_w, conv_b, dt_bias, a_log, d_skip, norm_g, s0):
    b, t, _ = u.shape
    z, xbc, dt_raw = _split(u, [D_SSD, D_SSD + 2 * SSD_BC, 2 * SSD_HEADS])
    xbc = jax.nn.silu(_dwconv_centred(xbc, conv_w, conv_b))
    xs, bm, cm = _split(xbc, [D_SSD, SSD_BC, SSD_BC])
    xs = xs.reshape(b, t, SSD_HEADS, HEAD_DIM)
    rep = SSD_HEADS // SSD_GROUPS
    bh = jnp.repeat(bm.reshape(b, t, SSD_GROUPS, SSD_STATE), rep, axis=2)
    ch = jnp.repeat(cm.reshape(b, t, SSD_GROUPS, SSD_STATE), rep, axis=2)
    dt = jax.nn.softplus(dt_raw.reshape(b, t, 2, SSD_HEADS) + dt_bias)
    a = -jnp.exp(a_log)
    y_f, s_f = _bidir(functools.partial(_ssd_scan, a[0]), (xs, dt[:, :, 0], bh, ch), s0[:, 0], False)
    y_b, s_b = _bidir(functools.partial(_ssd_scan, a[1]), (xs, dt[:, :, 1], bh, ch), s0[:, 1], True)
    y = (y_f + y_b + d_skip[:, None] * xs).reshape(b, t, D_SSD) * jax.nn.silu(z)
    return _group_norm(y, norm_g, SSD_GROUPS, center=False), jnp.stack([s_f, s_b], axis=1)


def _rwkv_mixer(u, grid_w, mu, w0, w2, a0, a2, g2, k_k, k_a, r_k, norm_g, s0):
    b, t, _ = u.shape
    shifted = _grid_shift(u, grid_w) if grid_w else _seq_shift(u)
    u = u + (shifted - u) * mu
    r, k, v, xw, xa, xg = _split(u, [D_RWKV, D_RWKV, D_RWKV, 2 * LORA_W, 2 * LORA_A, LORA_G])

    def heads(z):
        return z.reshape(b, t, RWKV_HEADS, HEAD_DIM)

    w_log = -jax.nn.softplus(-(w0 + jnp.einsum('btdr,drc->btdc', jnp.tanh(xw.reshape(b, t, 2, LORA_W)), w2))) - 0.5
    decay = jnp.exp(-jnp.exp(w_log))
    lr = jax.nn.sigmoid(a0 + jnp.einsum('btdr,drc->btdc', xa.reshape(b, t, 2, LORA_A), a2))
    gate = jax.nn.sigmoid(xg) @ g2
    kkf = heads(k * k_k).astype(jnp.float32)
    kk = (kkf * lax.rsqrt(jnp.sum(kkf * kkf, axis=-1, keepdims=True) + 1e-12)).astype(u.dtype)
    rh, vh, rkh = heads(r), heads(v), r_k.reshape(RWKV_HEADS, HEAD_DIM)

    def direction(d, reverse):
        kd = heads(k * (1 + (lr[:, :, d] - 1) * k_a))
        y, s = _bidir(_rwkv7_scan, (rh, heads(decay[:, :, d]), kd, vh, kk, heads(lr[:, :, d])), s0[:, d], reverse)
        return y + jnp.sum(rh * kd * rkh, axis=-1, keepdims=True) * vh, s

    o_f, s_f = direction(0, False)
    o_b, s_b = direction(1, True)
    y = _group_norm((o_f + o_b).reshape(b, t, D_RWKV), norm_g, RWKV_HEADS, center=True) * gate
    return y, jnp.stack([s_f, s_b], axis=1)


def _mlstm_mixer(u, conv_w, conv_b, i_bias, f_bias, norm_g, c0, n0, m0):
    b, t, _ = u.shape
    qk, v, o, gates = _split(u, [2 * D_MLSTM, D_MLSTM, D_MLSTM, 4 * MLSTM_HEADS])
    q, k = _split(jax.nn.silu(_dwconv_centred(qk, conv_w, conv_b)), [D_MLSTM, D_MLSTM])

    def heads(z):
        return z.reshape(b, t, MLSTM_HEADS, HEAD_DIM)

    q, k, v = heads(q), heads(k) * (HEAD_DIM ** -0.5), heads(v)
    gates = gates.reshape(b, t, 2, 2, MLSTM_HEADS)
    ig = gates[:, :, :, 0] + i_bias
    lf = jax.nn.log_sigmoid(gates[:, :, :, 1] + f_bias)
    h_f, (c_f, n_f, m_f) = _bidir(_mlstm_chunked, (q, k, v, ig[:, :, 0], lf[:, :, 0]),
                                  (c0[:, 0], n0[:, 0], m0[:, 0]), False)
    h_b, (c_b, n_b, m_b) = _bidir(_mlstm_chunked, (q, k, v, ig[:, :, 1], lf[:, :, 1]),
                                  (c0[:, 1], n0[:, 1], m0[:, 1]), True)
    y = _group_norm((h_f + h_b).reshape(b, t, D_MLSTM), norm_g, MLSTM_HEADS, center=True) * jax.nn.sigmoid(o)
    return y, (jnp.stack([c_f, c_b], axis=1), jnp.stack([n_f, n_b], axis=1), jnp.stack([m_f, m_b], axis=1))


def _ada(cond, w, b):
    return jax.nn.silu(cond) @ w + b


def _trunk_layer(x, mod, p, states, grid_w):
    sh1, sc1, g1, sh2, sc2, g2 = jnp.split(mod, 6, axis=-1)
    h = _rms_norm(x, p['norm1_g']) * (1 + sc1) + sh1
    u = h @ p['w_in']
    u_ssd, u_rwkv, u_ml = _split(u, [SSD_COLS, RWKV_COLS, MLSTM_COLS])
    s_ssd, s_rwkv, s_c, s_n, s_m = states
    y_ssd, n_ssd = _ssd_mixer(u_ssd, p['ssd_conv_w'], p['ssd_conv_b'], p['ssd_dt_bias'], p['ssd_a_log'],
                              p['ssd_d'], p['ssd_norm_g'], s_ssd)
    y_rwkv, n_rwkv = _rwkv_mixer(u_rwkv, grid_w, p['rwkv_mu'], p['rwkv_w0'], p['rwkv_w2'], p['rwkv_a0'],
                                 p['rwkv_a2'], p['rwkv_g2'], p['rwkv_k_k'], p['rwkv_k_a'], p['rwkv_r_k'],
                                 p['rwkv_norm_g'], s_rwkv)
    y_ml, (n_c, n_n, n_m) = _mlstm_mixer(u_ml, p['mlstm_conv_w'], p['mlstm_conv_b'], p['mlstm_i_bias'],
                                         p['mlstm_f_bias'], p['mlstm_norm_g'], s_c, s_n, s_m)
    y = jnp.concatenate([y_ssd, y_rwkv, y_ml], axis=-1) @ p['w_out']
    x = x + g1 * y
    h = _rms_norm(x, p['norm2_g']) * (1 + sc2) + sh2
    x = x + g2 * ((jax.nn.silu(h @ p['ffn_w1']) * (h @ p['ffn_w3'])) @ p['ffn_w2'])
    return x, (n_ssd, n_rwkv, n_c, n_n, n_m)


def setup_inputs(seed: int = 0) -> dict:
    key = jax.random.key(seed)
    ks = iter(jax.random.split(key, 64))

    def nrm(shape, scale):
        return scale * jax.random.normal(next(ks), shape, jnp.float32)

    def uni(shape, lo, hi):
        return jax.random.uniform(next(ks), shape, jnp.float32, lo, hi)

    D = D_MODEL
    L2 = (DEPTH, 2)
    dt0 = jnp.exp(uni(L2 + (SSD_HEADS,), math.log(1e-3), math.log(1e-1)))
    return {
        'x_prompt': nrm((BATCH, SEQ, D), 1.0),
        'x_sample': nrm((DEC_BATCH, DEC_SEQ, D), 1.0),
        'state_ssd': nrm((DEC_BATCH, DEPTH, 2, SSD_HEADS, HEAD_DIM, SSD_STATE), 0.1),
        'state_rwkv': nrm((DEC_BATCH, DEPTH, 2, RWKV_HEADS, HEAD_DIM, HEAD_DIM), 0.5),
        'state_mlstm_c': nrm((DEC_BATCH, DEPTH, 2, MLSTM_HEADS, HEAD_DIM, HEAD_DIM), 0.5),
        'state_mlstm_n': nrm((DEC_BATCH, DEPTH, 2, MLSTM_HEADS, HEAD_DIM), 0.5),
        'state_mlstm_m': nrm((DEC_BATCH, DEPTH, 2, MLSTM_HEADS), 1.0),
        'c': nrm((DEC_BATCH, D), 1.0),
        'c_ctx': nrm((D,), 1.0),
        'ada_w': nrm((DEPTH, D, 6 * D), 0.5 * D ** -0.5),
        'ada_b': nrm((DEPTH, 6 * D), 0.02),
        'norm1_g': 1.0 + nrm((DEPTH, D), 0.02),
        'norm2_g': 1.0 + nrm((DEPTH, D), 0.02),
        'w_in': nrm((DEPTH, D, D_IN), D ** -0.5),
        'ssd_conv_w': nrm((DEPTH, CONV_W, D_SSD + 2 * SSD_BC), CONV_W ** -0.5),
        'ssd_conv_b': nrm((DEPTH, D_SSD + 2 * SSD_BC), 0.02),
        'ssd_dt_bias': dt0 + jnp.log(-jnp.expm1(-dt0)),
        'ssd_a_log': jnp.log(uni(L2 + (SSD_HEADS,), 1.0, 16.0)),
        'ssd_d': 1.0 + nrm((DEPTH, SSD_HEADS), 0.1),
        'ssd_norm_g': 1.0 + nrm((DEPTH, D_SSD), 0.02),
        'rwkv_mu': uni((DEPTH, RWKV_COLS), 0.0, 1.0),
        'rwkv_w0': uni(L2 + (D_RWKV,), -3.0, 1.0),
        'rwkv_w2': nrm(L2 + (LORA_W, D_RWKV), 0.5 * LORA_W ** -0.5),
        'rwkv_a0': nrm(L2 + (D_RWKV,), 0.5),
        'rwkv_a2': nrm(L2 + (LORA_A, D_RWKV), 0.5 * LORA_A ** -0.5),
        'rwkv_g2': nrm((DEPTH, LORA_G, D_RWKV), LORA_G ** -0.5),
        'rwkv_k_k': 0.85 + nrm((DEPTH, D_RWKV), 0.05),
        'rwkv_k_a': 1.0 + nrm((DEPTH, D_RWKV), 0.05),
        'rwkv_r_k': nrm((DEPTH, D_RWKV), 0.1),
        'rwkv_norm_g': 1.0 + nrm((DEPTH, D_RWKV), 0.02),
        'mlstm_conv_w': nrm((DEPTH, CONV_W, 2 * D_MLSTM), CONV_W ** -0.5),
        'mlstm_conv_b': nrm((DEPTH, 2 * D_MLSTM), 0.02),
        'mlstm_i_bias': nrm(L2 + (MLSTM_HEADS,), 0.1),
        'mlstm_f_bias': uni(L2 + (MLSTM_HEADS,), 3.0, 6.0),
        'mlstm_norm_g': 1.0 + nrm((DEPTH, D_MLSTM), 0.02),
        'w_out': nrm((DEPTH, D_MIX, D), D_MIX ** -0.5),
        'ffn_w1': nrm((DEPTH, D, D_FF), D ** -0.5),
        'ffn_w3': nrm((DEPTH, D, D_FF), D ** -0.5),
        'ffn_w2': nrm((DEPTH, D_FF, D), D_FF ** -0.5),
        'final_norm_g': 1.0 + nrm((D,), 0.02),
    }


def reference(x_prompt, x_sample, state_ssd, state_rwkv, state_mlstm_c, state_mlstm_n, state_mlstm_m, c,
              c_ctx, ada_w, ada_b, norm1_g, norm2_g, w_in, ssd_conv_w, ssd_conv_b, ssd_dt_bias, ssd_a_log,
              ssd_d, ssd_norm_g, rwkv_mu, rwkv_w0, rwkv_w2, rwkv_a0, rwkv_a2, rwkv_g2, rwkv_k_k, rwkv_k_a,
              rwkv_r_k, rwkv_norm_g, mlstm_conv_w, mlstm_conv_b, mlstm_i_bias, mlstm_f_bias, mlstm_norm_g,
              w_out, ffn_w1, ffn_w3, ffn_w2, final_norm_g):
    bp = x_prompt.shape[0]
    dt_ = x_prompt.dtype
    zero_states = (jnp.zeros((bp, 2, SSD_HEADS, HEAD_DIM, SSD_STATE), dt_),
                   jnp.zeros((bp, 2, RWKV_HEADS, HEAD_DIM, HEAD_DIM), dt_),
                   jnp.zeros((bp, 2, MLSTM_HEADS, HEAD_DIM, HEAD_DIM), dt_),
                   jnp.zeros((bp, 2, MLSTM_HEADS, HEAD_DIM), dt_),
                   jnp.zeros((bp, 2, MLSTM_HEADS), dt_))
    xp, xs = x_prompt, x_sample
    ctx_states = []
    for l in range(DEPTH):
        p = dict(norm1_g=norm1_g[l], norm2_g=norm2_g[l], w_in=w_in[l],
                 ssd_conv_w=ssd_conv_w[l], ssd_conv_b=ssd_conv_b[l], ssd_dt_bias=ssd_dt_bias[l],
                 ssd_a_log=ssd_a_log[l], ssd_d=ssd_d[l], ssd_norm_g=ssd_norm_g[l],
                 rwkv_mu=rwkv_mu[l], rwkv_w0=rwkv_w0[l], rwkv_w2=rwkv_w2[l], rwkv_a0=rwkv_a0[l],
                 rwkv_a2=rwkv_a2[l], rwkv_g2=rwkv_g2[l], rwkv_k_k=rwkv_k_k[l], rwkv_k_a=rwkv_k_a[l],
                 rwkv_r_k=rwkv_r_k[l], rwkv_norm_g=rwkv_norm_g[l],
                 mlstm_conv_w=mlstm_conv_w[l], mlstm_conv_b=mlstm_conv_b[l], mlstm_i_bias=mlstm_i_bias[l],
                 mlstm_f_bias=mlstm_f_bias[l], mlstm_norm_g=mlstm_norm_g[l],
                 w_out=w_out[l], ffn_w1=ffn_w1[l], ffn_w3=ffn_w3[l], ffn_w2=ffn_w2[l])
        mod_ctx = _ada(c_ctx, ada_w[l], ada_b[l])[None, None, :]
        mod_lat = _ada(c, ada_w[l], ada_b[l])[:, None, :]
        xp, st = _trunk_layer(xp, mod_ctx, p, zero_states, None)
        ctx_states.append(st)
        cached = (state_ssd[:, l], state_rwkv[:, l], state_mlstm_c[:, l], state_mlstm_n[:, l], state_mlstm_m[:, l])
        xs, _ = _trunk_layer(xs, mod_lat, p, cached, GRID_W)
    y_prompt = _rms_norm(xp, final_norm_g)
    y_sample = _rms_norm(xs, final_norm_g)
    new_state_ssd = jnp.stack([s[0] for s in ctx_states], axis=1)
    new_state_rwkv = jnp.stack([s[1] for s in ctx_states], axis=1)
    new_state_mlstm_c = jnp.stack([s[2] for s in ctx_states], axis=1)
    new_state_mlstm_n = jnp.stack([s[3] for s in ctx_states], axis=1)
    new_state_mlstm_m = jnp.stack([s[4] for s in ctx_states], axis=1)
    return (y_prompt, y_sample, new_state_ssd, new_state_rwkv, new_state_mlstm_c, new_state_mlstm_n, new_state_mlstm_m)
```

```cpp
#include <hip/hip_runtime.h>
#include <hip/hip_cooperative_groups.h>
#include <cstdio>
namespace cg = cooperative_groups;
#ifndef ONE_LAUNCH
#define ONE_LAUNCH 0
#endif
namespace pg8 {
#define PG8_LAS __attribute__((address_space(3)))
typedef unsigned short bf16_t;
typedef short bf16x8 __attribute__((ext_vector_type(8)));
typedef float f32x4 __attribute__((ext_vector_type(4)));
typedef unsigned u32x4 __attribute__((ext_vector_type(4)));
constexpr int BM = 256, BK = 64, HALF = 128, HTB = HALF * BK * 2  , STAGE_BYTES = 8 * HTB, NXCD = 8, WGM = 8;

__host__ __device__ __forceinline__ int lds_byte(int r, int c) { const int st = (r >> 4) * 2 + (c >> 5), rr = r & 15, cc = c & 31, ob = rr * 64 + cc * 2; return st * 1024 + (ob ^ (((ob >> 9) & 1) << 5)); }
__host__ __device__ __forceinline__ void stage_rc(int b, int& R, int& C) { const int st = b / 1024, sb = b % 1024, swz = sb ^ (((sb >> 9) & 1) << 5); R = (st >> 1) * 16 + swz / 64; C = (st & 1) * 32 + (swz % 64) / 2; }
__host__ __device__ __forceinline__ int perm32(int rho) { const int n = rho >> 4, i = rho & 15; return 8 * (i >> 2) + 4 * n + (i & 3); }

struct Unit { int pm, pn; };
struct Gemm { const bf16_t* A; const bf16_t* Bt; int M, N, K; };

struct StaticOrder {
    int nM, nN, nwg, G, c;
    __host__ __device__ void init(int M, int N, int G_, int c_) { nM = M / BM; nN = N / BM; nwg = nM * nN; G = G_; c = c_; }
    __host__ __device__ bool next(int i, Unit& u) const {
        const long L = (long)i * G + c; if (L >= nwg) return false;
        int wgid = (int)L; { const int q = nwg / NXCD, r = nwg % NXCD, xcd = wgid % NXCD, off = wgid / NXCD; wgid = (xcd < r ? xcd * (q + 1) : r * (q + 1) + (xcd - r) * q) + off; }
        const int nig = WGM * nN, gid = wgid / nig, fm = gid * WGM, gsz = (nM - fm) < WGM ? (nM - fm) : WGM;
        u.pm = fm + ((wgid % nig) % gsz); u.pn = (wgid % nig) / gsz; return true;
    }
    __device__ __forceinline__ void a_ready(const Unit&) const {}
    __device__ __forceinline__ void done(const Unit&) const {}
};
__device__ __forceinline__ unsigned cvt_pk_bf16(float lo, float hi) { unsigned r; asm volatile("v_cvt_pk_bf16_f32 %0, %1, %2" : "=v"(r) : "v"(lo), "v"(hi)); return r; }
template <class Epi, class Sched, bool STAMP = false>
__device__ __forceinline__ void gemm_phase(PG8_LAS unsigned char* lds, const Gemm g, const Sched& S, const Epi& E, unsigned long long* stamps) {
    int tid_l = threadIdx.x; asm volatile("" : "+v"(tid_l));
    const int tid = tid_l, wid = __builtin_amdgcn_readfirstlane(tid >> 6), lane = tid & 63, wr = wid >> 2, wc = wid & 3, fr = lane & 15, fq = lane >> 4;
    const int K = g.K, nt = K / BK;
    int ts_lo = 0, ts_hi = 0, nts = 0; const unsigned long long rt_entry = STAMP ? (unsigned long long)wall_clock64() : 0ull;
#define PG8_STAMP() do { if (STAMP && wid == 0 && nts < 64) { const unsigned long long _c = (unsigned long long)clock64(); \
        ts_lo = (lane == nts) ? (int)(unsigned)_c : ts_lo; ts_hi = (lane == nts) ? (int)(unsigned)(_c >> 32) : ts_hi; ++nts; } } while (0)
    PG8_STAMP();
    unsigned voffA[2], voffB[2];
#pragma unroll
    for (int i = 0; i < 2; ++i) { int R, C; stage_rc(tid * 16 + i * 8192, R, C); const int Rb = Epi::PERM ? ((R & ~31) + perm32(R & 31)) : R;
        voffA[i] = (unsigned)(R * K + C) * 2u; voffB[i] = (unsigned)(Rb * K + C) * 2u; }
    const size_t kstep = (size_t)(BK * 2);
    const size_t hstep = (size_t)HALF * K * 2;
    const size_t tstep = 2 * hstep;
    const unsigned ldsw = (unsigned)wid * 1024u;
    const int aoff = lds_byte(wr * 64 + fr, fq * 8), boff = lds_byte(wc * 32 + fr, fq * 8);
#define PG8_SA(b, h) (((b) * 2 + (h)) * HTB)
#define PG8_SB(b, h) ((4 + (b) * 2 + (h)) * HTB)
#define PG8_STAGE(bufoff, gbase, voff) do { _Pragma("unroll") for (int _i = 0; _i < 2; ++_i) \
        __builtin_amdgcn_global_load_lds((const unsigned*)((const char*)(gbase) + (voff)[_i]), (PG8_LAS unsigned*)(lds + (bufoff) + ldsw + _i * 8192), 16, 0, 0); } while (0)
#define PG8_LDA(dst, b, h) do { _Pragma("unroll") for (int m = 0; m < 4; ++m) _Pragma("unroll") for (int k = 0; k < 2; ++k) dst[m][k] = *(const PG8_LAS bf16x8*)(lds + PG8_SA(b, h) + aoff + m * 2048 + k * 1024); } while (0)
#define PG8_LDB(dst, b, h) do { _Pragma("unroll") for (int n = 0; n < 2; ++n) _Pragma("unroll") for (int k = 0; k < 2; ++k) dst[n][k] = *(const PG8_LAS bf16x8*)(lds + PG8_SB(b, h) + boff + n * 2048 + k * 1024); } while (0)
#define PG8_MMA(ai, bj, At, Bt) do { __builtin_amdgcn_s_setprio(1); _Pragma("unroll") for (int m = 0; m < 4; ++m) _Pragma("unroll") for (int n = 0; n < 2; ++n) _Pragma("unroll") for (int k = 0; k < 2; ++k) \
        acc[ai][bj][m][n] = __builtin_amdgcn_mfma_f32_16x16x32_bf16(Bt[n][k], At[m][k], acc[ai][bj][m][n], 0, 0, 0); __builtin_amdgcn_s_setprio(0); } while (0)
#define PG8_WAIT_V(n) asm volatile("s_waitcnt vmcnt(" #n ")" ::: "memory")
#define PG8_WAIT_L(n) asm volatile("s_waitcnt lgkmcnt(" #n ")" ::: "memory")
#define PG8_BAR __builtin_amdgcn_s_barrier()
#define PG8_SCHED __builtin_amdgcn_sched_barrier(0)
    Unit cur, nxt; int ui = 0;
    if (!S.next(0, cur)) return;
    f32x4 acc[2][2][4][2];
#pragma unroll
    for (int a = 0; a < 2; ++a)
#pragma unroll
        for (int b = 0; b < 2; ++b)
#pragma unroll
            for (int m = 0; m < 4; ++m)
#pragma unroll
                for (int n = 0; n < 2; ++n) acc[a][b][m][n] = (f32x4){0.f, 0.f, 0.f, 0.f};
    bf16x8 At[4][2], B0[2][2], B1[2][2];
    const char* cA = (const char*)g.A + (size_t)cur.pm * tstep; const char* cB = (const char*)g.Bt + (size_t)cur.pn * tstep;
    S.a_ready(cur);
    PG8_STAGE(PG8_SB(0, 0), cB, voffB); PG8_STAGE(PG8_SA(0, 0), cA, voffA); PG8_STAGE(PG8_SB(0, 1), cB + hstep, voffB); PG8_STAGE(PG8_SA(0, 1), cA + hstep, voffA);
    if (wr == 1) PG8_BAR;
    PG8_WAIT_V(4); PG8_BAR;
    PG8_STAGE(PG8_SB(1, 0), cB + kstep, voffB); PG8_STAGE(PG8_SA(1, 0), cA + kstep, voffA); PG8_STAGE(PG8_SB(1, 1), cB + hstep + kstep, voffB);
    PG8_WAIT_V(6); PG8_BAR;
    PG8_STAMP();
    for (;;) {
        const bool has_next = S.next(ui + 1, nxt);
        const char* nA = has_next ? (const char*)g.A + (size_t)nxt.pm * tstep : cA; const char* nB = has_next ? (const char*)g.Bt + (size_t)nxt.pn * tstep : cB;
        for (int t = 0; t < nt; t += 2) {
            const bool last = (t == nt - 2);
            const char* a1 = cA + (size_t)(t + 1) * kstep;
            const char* a2 = last ? nA : cA + (size_t)(t + 2) * kstep; const char* b2 = last ? nB : cB + (size_t)(t + 2) * kstep;
            const char* a3 = a2 + kstep; const char* b3 = b2 + kstep;
            if (last && has_next) S.a_ready(nxt);
            PG8_LDB(B0, 0, 0); PG8_SCHED; PG8_LDA(At, 0, 0); PG8_STAGE(PG8_SA(1, 1), a1 + hstep, voffA);
            PG8_WAIT_L(8); PG8_BAR; PG8_WAIT_L(0); PG8_MMA(0, 0, At, B0); PG8_BAR; PG8_SCHED;
            PG8_LDB(B1, 0, 1); PG8_STAGE(PG8_SB(0, 0), b2, voffB);
            PG8_BAR; PG8_WAIT_L(0); PG8_MMA(0, 1, At, B1); PG8_BAR;
            PG8_LDA(At, 0, 1); PG8_STAGE(PG8_SA(0, 0), a2, voffA);
            PG8_BAR; PG8_WAIT_L(0); PG8_MMA(1, 0, At, B0); PG8_BAR; PG8_SCHED;
            PG8_STAGE(PG8_SB(0, 1), b2 + hstep, voffB);
            PG8_WAIT_V(6); PG8_BAR; PG8_MMA(1, 1, At, B1); PG8_BAR;
            PG8_LDB(B0, 1, 0); PG8_SCHED; PG8_LDA(At, 1, 0); PG8_STAGE(PG8_SA(0, 1), a2 + hstep, voffA);
            PG8_WAIT_L(8); PG8_BAR; PG8_WAIT_L(0); PG8_MMA(0, 0, At, B0); PG8_BAR; PG8_SCHED;
            PG8_LDB(B1, 1, 1); PG8_STAGE(PG8_SB(1, 0), b3, voffB);
            PG8_BAR; PG8_WAIT_L(0); PG8_MMA(0, 1, At, B1); PG8_BAR;
            PG8_LDA(At, 1, 1); PG8_STAGE(PG8_SA(1, 0), a3, voffA);
            PG8_BAR; PG8_WAIT_L(0); PG8_MMA(1, 0, At, B0); PG8_BAR; PG8_SCHED;
            PG8_STAGE(PG8_SB(1, 1), b3 + hstep, voffB);
            PG8_WAIT_V(6); PG8_BAR; PG8_MMA(1, 1, At, B1); PG8_BAR;
        }
        PG8_STAMP();
        if constexpr (!Epi::AFTER_DRAIN) { E(acc, cur, wr, wc, fr, fq); S.done(cur); }
        PG8_STAMP();
        if (!has_next) break;
#pragma unroll
        for (int a = 0; a < 2; ++a)
#pragma unroll
            for (int b = 0; b < 2; ++b)
#pragma unroll
                for (int m = 0; m < 4; ++m)
#pragma unroll
                    for (int n = 0; n < 2; ++n) acc[a][b][m][n] = (f32x4){0.f, 0.f, 0.f, 0.f};
        cur = nxt; cA = nA; cB = nB; ++ui;
    }
    PG8_WAIT_V(0);
    if (wr == 0) PG8_BAR;
    PG8_BAR;
    if constexpr (Epi::AFTER_DRAIN) { E.fused(acc, cur, wr, wc, fr, fq, lds, wid, lane); S.done(cur); }
    PG8_STAMP();
    if (STAMP && wid == 0) { stamps[lane] = lane < nts ? (((unsigned long long)(unsigned)ts_hi << 32) | (unsigned)ts_lo) : 0ull;
        if (lane == 62) stamps[62] = rt_entry; if (lane == 63) stamps[63] = (unsigned long long)wall_clock64(); }
#undef PG8_STAMP
#undef PG8_SA
#undef PG8_SB
#undef PG8_STAGE
#undef PG8_LDA
#undef PG8_LDB
#undef PG8_MMA
#undef PG8_WAIT_V
#undef PG8_WAIT_L
#undef PG8_BAR
#undef PG8_SCHED
}
}
namespace mk {
using pg8::bf16_t; using pg8::f32x4; using pg8::u32x4; using pg8::Unit;
#define LAS __attribute__((address_space(3)))
typedef unsigned u32x2 __attribute__((ext_vector_type(2)));
constexpr int MT = 40960, NCTX = 8192;
constexpr int NR = 1024, NS = 1536, NM = 1280;
constexpr size_t SZ_WR = 2ull * NR * 1024 * 2, SZ_WS = 2ull * NS * 1024 * 2, SZ_WM = 2ull * NM * 1024 * 2, SZ_WO = 2ull * 1024 * 1024 * 2, SZ_W13 = 2ull * 5632 * 1024 * 2, SZ_W2 = 2ull * 1024 * 2816 * 2;
constexpr size_t OFF_WR = 0, OFF_WS = OFF_WR + SZ_WR, OFF_WM = OFF_WS + SZ_WS, OFF_WO = OFF_WM + SZ_WM, OFF_W13 = OFF_WO + SZ_WO, OFF_W2 = OFF_W13 + SZ_W13, OFF_MOD = OFF_W2 + SZ_W2;
constexpr size_t SZ_MOD = 2ull * 9 * 6144 * 4;
constexpr size_t COLB = (size_t)MT * 2;
constexpr size_t OFF_H = OFF_MOD + SZ_MOD, OFF_OR = OFF_H + 1024 * COLB, OFF_GR = OFF_OR + 512 * COLB, OFF_BIG = OFF_GR + 256 * COLB;
constexpr size_t OFF_UR = OFF_BIG, OFF_PR = OFF_BIG + 1024 * COLB;
constexpr size_t OFF_OS = OFF_BIG, OFF_ZS = OFF_BIG + 1024 * COLB, OFF_US = OFF_BIG + 1536 * COLB, OFF_PS = OFF_BIG + 3072 * COLB, OFF_DT = OFF_BIG + 3840 * COLB;
constexpr size_t OFF_OM = OFF_BIG + 1536 * COLB, OFF_UM = OFF_BIG + 2048 * COLB, OFF_PM = OFF_BIG + 3328 * COLB, OFF_GM = OFF_BIG + 3840 * COLB;
constexpr size_t OFF_ACT = OFF_BIG;
constexpr size_t WS_END = OFF_BIG + 3904 * COLB;
constexpr size_t OS_SSD = 41943040ull, OS_RWKV = OS_SSD + 4194304ull, OS_MC = OS_RWKV + 2097152ull, OS_MN = OS_MC + 2097152ull, OS_MM = OS_MN + 32768ull;
constexpr int LDS_BYTES = 131072;

struct Params { const float* in[40]; float* out; unsigned char* ws; int ph_lo, ph_hi; };

__device__ __forceinline__ int otid() { int t = threadIdx.x; asm volatile("" : "+v"(t)); return t; }
__device__ __forceinline__ float bf2f(unsigned v) { return __uint_as_float(v << 16); }
__device__ __forceinline__ float bflo(unsigned w) { return __uint_as_float(w << 16); }
__device__ __forceinline__ float bfhi(unsigned w) { return __uint_as_float(w & 0xffff0000u); }
__device__ __forceinline__ bf16_t f2bf(float f) { unsigned u = __float_as_uint(f); u += 0x7FFFu + ((u >> 16) & 1u); return (bf16_t)(u >> 16); }
__device__ __forceinline__ unsigned pk2(float lo, float hi) { return (unsigned)f2bf(lo) | ((unsigned)f2bf(hi) << 16); }
__device__ __forceinline__ float sigmoidf_(float x) { return 1.f / (1.f + __expf(-x)); }
__device__ __forceinline__ float siluf_(float x) { return x / (1.f + __expf(-x)); }
__device__ __forceinline__ float softplusf_(float x) { return fmaxf(x, 0.f) + log1pf(__expf(-fabsf(x))); }
__device__ __forceinline__ float tanhf_(float x) { return 1.f - 2.f / (__expf(2.f * x) + 1.f); }
template <int CTRL> __device__ __forceinline__ float dppmov(float x) { return __int_as_float(__builtin_amdgcn_update_dpp(0, __float_as_int(x), CTRL, 0xF, 0xF, true)); }
template <int LPR> __device__ __forceinline__ float row_allreduce(float x) {
    x += dppmov<0xB1>(x); x += dppmov<0x4E>(x); x += dppmov<0x141>(x);
    if (LPR == 16) x += dppmov<0x140>(x);
    return x;
}
__device__ __forceinline__ float wave_sum(float x) {
    x = row_allreduce<16>(x);
    const int xi = __float_as_int(x);
    return __int_as_float(__builtin_amdgcn_readlane(xi, 0)) + __int_as_float(__builtin_amdgcn_readlane(xi, 16)) + __int_as_float(__builtin_amdgcn_readlane(xi, 32)) + __int_as_float(__builtin_amdgcn_readlane(xi, 48));
}
__device__ __forceinline__ const float* xsrc_row(const Params& p, int l, int r) {
    if (l == 0) return r < NCTX ? p.in[0] + (size_t)r * 1024 : p.in[1] + (size_t)(r - NCTX) * 1024;
    return p.out + (size_t)r * 1024;
}
__device__ __forceinline__ int cond_of_row(int r) { return r < NCTX ? 0 : 1 + ((r - NCTX) >> 12); }

__device__ void transpose_job(const float* src, int K, int Nsrc, int c0, int ncols, int Npad, bf16_t* dst, int mode, float* tile) {
    const int tid = otid(), lane = tid & 63, w = __builtin_amdgcn_readfirstlane(tid >> 6);
    const int nkt = K / 64, nnt = Npad / 64;
    for (int it = blockIdx.x; it < nkt * nnt; it += gridDim.x) {
        const int kt = it / nnt, nt = it % nnt, k0 = kt * 64, n0 = nt * 64;
        const int n = n0 + lane;
        for (int i = w; i < 64; i += 8) tile[i * 65 + lane] = (n < ncols) ? src[(size_t)(k0 + i) * Nsrc + c0 + n] : 0.f;
        __syncthreads();
        {
            const int nn = tid >> 3, kc = (tid & 7) * 8, ng = n0 + nn;
            const int drow = mode == 0 ? ng : ((ng >> 7) * 256 + (ng & 127) + (mode == 2 ? 128 : 0));
            u32x4 o;
            o.x = pk2(tile[(kc + 0) * 65 + nn], tile[(kc + 1) * 65 + nn]); o.y = pk2(tile[(kc + 2) * 65 + nn], tile[(kc + 3) * 65 + nn]);
            o.z = pk2(tile[(kc + 4) * 65 + nn], tile[(kc + 5) * 65 + nn]); o.w = pk2(tile[(kc + 6) * 65 + nn], tile[(kc + 7) * 65 + nn]);
            *(u32x4*)(dst + (size_t)drow * K + k0 + kc) = o;
        }
        __syncthreads();
    }
}
__device__ void prologue_phase(const Params& p, float* sm) {
    for (int l = 0; l < 2; ++l) {
        const float* win = p.in[13] + (size_t)l * 1024 * 3296;
        transpose_job(win, 1024, 3296, 1296, 960, NR, (bf16_t*)(p.ws + OFF_WR) + (size_t)l * NR * 1024, 0, sm);
        transpose_job(win, 1024, 3296, 0, 1296, NS, (bf16_t*)(p.ws + OFF_WS) + (size_t)l * NS * 1024, 0, sm);
        transpose_job(win, 1024, 3296, 2256, 1040, NM, (bf16_t*)(p.ws + OFF_WM) + (size_t)l * NM * 1024, 0, sm);
        transpose_job(p.in[35] + (size_t)l * 1024 * 1024, 1024, 1024, 0, 1024, 1024, (bf16_t*)(p.ws + OFF_WO) + (size_t)l * 1024 * 1024, 0, sm);
        transpose_job(p.in[36] + (size_t)l * 1024 * 2816, 1024, 2816, 0, 2816, 2816, (bf16_t*)(p.ws + OFF_W13) + (size_t)l * 5632 * 1024, 1, sm);
        transpose_job(p.in[37] + (size_t)l * 1024 * 2816, 1024, 2816, 0, 2816, 2816, (bf16_t*)(p.ws + OFF_W13) + (size_t)l * 5632 * 1024, 2, sm);
        transpose_job(p.in[38] + (size_t)l * 2816 * 1024, 2816, 1024, 0, 1024, 1024, (bf16_t*)(p.ws + OFF_W2) + (size_t)l * 1024 * 2816, 0, sm);
    }
    const int tid = otid(), lane = tid & 63, kg = __builtin_amdgcn_readfirstlane(tid >> 6);
    float* red = sm + 9 * 1024;
    for (int i = tid; i < 9 * 1024; i += 512) { const int ci = i >> 10, k = i & 1023; const float v = ci == 0 ? p.in[8][k] : p.in[7][(ci - 1) * 1024 + k]; sm[i] = siluf_(v); }
    __syncthreads();
    float* mod = (float*)(p.ws + OFF_MOD);
    for (int it = blockIdx.x; it < 192; it += gridDim.x) {
        const int l = it / 96, nb = (it % 96) * 64;
        const float* W = p.in[9] + (size_t)l * 1024 * 6144 + nb + lane;
        float acc[9];
#pragma unroll
        for (int ci = 0; ci < 9; ++ci) acc[ci] = 0.f;
        for (int k = kg * 128; k < kg * 128 + 128; ++k) {
            const float w = W[(size_t)k * 6144];
#pragma unroll
            for (int ci = 0; ci < 9; ++ci) acc[ci] += sm[ci * 1024 + k] * w;
        }
#pragma unroll
        for (int ci = 0; ci < 9; ++ci) red[(kg * 9 + ci) * 64 + lane] = acc[ci];
        __syncthreads();
        for (int i = tid; i < 576; i += 512) {
            const int ci = i >> 6, ln = i & 63; float s = 0.f;
            for (int g = 0; g < 8; ++g) s += red[(g * 9 + ci) * 64 + ln];
            mod[(size_t)(l * 9 + ci) * 6144 + nb + ln] = s + p.in[10][l * 6144 + nb + ln];
        }
        __syncthreads();
    }
}

__device__ void norm_phase(const Params& p, int l, int which) {
    const int lane = otid() & 63, gw = blockIdx.x * 8 + __builtin_amdgcn_readfirstlane(otid() >> 6), nw = gridDim.x * 8;
    const float* g = p.in[which ? 12 : 11] + l * 1024;
    const float* mod = (const float*)(p.ws + OFF_MOD) + (size_t)l * 9 * 6144;
    bf16_t* H = (bf16_t*)(p.ws + OFF_H);
    const int sh_off = which ? 3072 : 0, sc_off = which ? 4096 : 1024;
    for (int r = gw; r < MT; r += nw) {
        const float* x = which == 0 ? xsrc_row(p, l, r) : p.out + (size_t)r * 1024;
        f32x4 v[4]; float ss = 0.f;
#pragma unroll
        for (int j = 0; j < 4; ++j) { v[j] = ((const f32x4*)x)[lane + 64 * j]; ss += v[j].x * v[j].x + v[j].y * v[j].y + v[j].z * v[j].z + v[j].w * v[j].w; }
#pragma unroll
        for (int o = 1; o < 64; o <<= 1) ss += __shfl_xor(ss, o);
        const float rstd = rsqrtf(ss * (1.f / 1024.f) + 1e-6f);
        const float* mc = mod + cond_of_row(r) * 6144;
#pragma unroll
        for (int j = 0; j < 4; ++j) {
            const int col = (lane + 64 * j) * 4;
            const f32x4 gg = *(const f32x4*)(g + col), sc = *(const f32x4*)(mc + sc_off + col), sh = *(const f32x4*)(mc + sh_off + col);
            const f32x4 o = v[j] * rstd * gg * (sc + 1.f) + sh;
            u32x2 w; w.x = pk2(o.x, o.y); w.y = pk2(o.z, o.w);
            *(u32x2*)(H + (size_t)r * 1024 + col) = w;
        }
    }
}
__device__ void final_norm_phase(const Params& p) {
    const int lane = otid() & 63, gw = blockIdx.x * 8 + __builtin_amdgcn_readfirstlane(otid() >> 6), nw = gridDim.x * 8;
    const float* g = p.in[39];
    for (int r = gw; r < MT; r += nw) {
        float* x = p.out + (size_t)r * 1024;
        f32x4 v[4]; float ss = 0.f;
#pragma unroll
        for (int j = 0; j < 4; ++j) { v[j] = ((const f32x4*)x)[lane + 64 * j]; ss += v[j].x * v[j].x + v[j].y * v[j].y + v[j].z * v[j].z + v[j].w * v[j].w; }
#pragma unroll
        for (int o = 1; o < 64; o <<= 1) ss += __shfl_xor(ss, o);
        const float rstd = rsqrtf(ss * (1.f / 1024.f) + 1e-6f);
#pragma unroll
        for (int j = 0; j < 4; ++j) { const int col = (lane + 64 * j) * 4; ((f32x4*)x)[lane + 64 * j] = v[j] * rstd * *(const f32x4*)(g + col); }
    }
}

struct EpiStoreBf16 {
    static constexpr bool PERM = true, AFTER_DRAIN = false;
    bf16_t* O; int ldc;
    __device__ __forceinline__ void operator()(const f32x4 (&acc)[2][2][4][2], const Unit& u, int wr, int wc, int fr, int fq) const {
        const int row0 = u.pm * 256 + wr * 64 + fr, col0 = u.pn * 256 + wc * 32 + 8 * fq;
#pragma unroll
        for (int ai = 0; ai < 2; ++ai)
#pragma unroll
            for (int m = 0; m < 4; ++m) { bf16_t* rowp = O + (size_t)(row0 + ai * 128 + m * 16) * ldc + col0;
#pragma unroll
                for (int bj = 0; bj < 2; ++bj) { const f32x4 v0 = acc[ai][bj][m][0], v1 = acc[ai][bj][m][1];
                    u32x4 w; w.x = pg8::cvt_pk_bf16(v0[0], v0[1]); w.y = pg8::cvt_pk_bf16(v0[2], v0[3]); w.z = pg8::cvt_pk_bf16(v1[0], v1[1]); w.w = pg8::cvt_pk_bf16(v1[2], v1[3]);
                    *(u32x4*)(rowp + bj * 128) = w; } }
    }
};
struct EpiSwiglu {
    static constexpr bool PERM = true, AFTER_DRAIN = false;
    bf16_t* O;
    __device__ __forceinline__ void operator()(const f32x4 (&acc)[2][2][4][2], const Unit& u, int wr, int wc, int fr, int fq) const {
        const int row0 = u.pm * 256 + wr * 64 + fr, col0 = u.pn * 128 + wc * 32 + 8 * fq;
#pragma unroll
        for (int ai = 0; ai < 2; ++ai)
#pragma unroll
            for (int m = 0; m < 4; ++m) { bf16_t* rowp = O + (size_t)(row0 + ai * 128 + m * 16) * 2816 + col0;
                f32x4 a[2];
#pragma unroll
                for (int n = 0; n < 2; ++n) { const f32x4 g = acc[ai][0][m][n], up = acc[ai][1][m][n];
#pragma unroll
                    for (int j = 0; j < 4; ++j) a[n][j] = g[j] / (1.f + __expf(-g[j])) * up[j]; }
                u32x4 w; w.x = pg8::cvt_pk_bf16(a[0][0], a[0][1]); w.y = pg8::cvt_pk_bf16(a[0][2], a[0][3]); w.z = pg8::cvt_pk_bf16(a[1][0], a[1][1]); w.w = pg8::cvt_pk_bf16(a[1][2], a[1][3]);
                *(u32x4*)rowp = w;
                asm volatile("" ::: "memory"); }
    }
};
struct EpiResidual {
    static constexpr bool PERM = false, AFTER_DRAIN = false;
    const float* xp; const float* xs; int from_inputs; float* out; const float* gate;
    __device__ __forceinline__ void operator()(const f32x4 (&acc)[2][2][4][2], const Unit& u, int wr, int wc, int fr, int fq) const {
        const int rb = u.pm * 256, row0 = rb + wr * 64 + fr, col0 = u.pn * 256 + wc * 32 + 4 * fq;
        const float* gp = gate + cond_of_row(rb) * 6144 + col0;
#pragma unroll
        for (int ai = 0; ai < 2; ++ai)
#pragma unroll
            for (int m = 0; m < 4; ++m) { const int r = row0 + ai * 128 + m * 16;
                const float* res = from_inputs ? (r < NCTX ? xp + (size_t)r * 1024 : xs + (size_t)(r - NCTX) * 1024) : out + (size_t)r * 1024;
                float* op = out + (size_t)r * 1024 + col0;
#pragma unroll
                for (int bj = 0; bj < 2; ++bj)
#pragma unroll
                    for (int n = 0; n < 2; ++n) { const f32x4 rv = *(const f32x4*)(res + col0 + bj * 128 + n * 16); const f32x4 gv = *(const f32x4*)(gp + bj * 128 + n * 16);
                        *(f32x4*)(op + bj * 128 + n * 16) = rv + gv * acc[ai][bj][m][n]; }
                asm volatile("" ::: "memory"); }
    }
};
template <class Epi> __device__ __forceinline__ void run_gemm(LAS unsigned char* lds, const bf16_t* A, const bf16_t* Bt, int N, int K, const Epi& E) {
    pg8::Gemm g{A, Bt, MT, N, K}; pg8::StaticOrder S; S.init(MT, N, (int)gridDim.x, (int)blockIdx.x);
    pg8::gemm_phase<Epi, pg8::StaticOrder, false>(lds, g, S, E, nullptr);
}
__device__ void prep_rwkv(const Params& p, int l, float* sm) {
    const int tid = otid(), lane = tid & 63, wid = __builtin_amdgcn_readfirstlane(tid >> 6);
    const bf16_t* U = (const bf16_t*)(p.ws + OFF_UR);
    bf16_t* P = (bf16_t*)(p.ws + OFF_PR);
    bf16_t* G = (bf16_t*)(p.ws + OFF_GR);
    const float* mu = p.in[20] + l * 960;
    float* um = sm; float* rs = sm + 16 * 960;
    const int c = tid & 255, half = tid >> 8;
    const float kkc = p.in[26][l * 256 + c];
    for (int tile = blockIdx.x; tile < MT / 16; tile += gridDim.x) {
        const int r0 = tile * 16;
        for (int i = tid; i < 16 * 480; i += 512) {
            const int tk = i / 480, cp = (i % 480) * 2, r = r0 + tk;
            const bf16_t* ur = U + (size_t)r * 1024 + cp;
            const unsigned uw = *(const unsigned*)ur;
            const float u0 = bflo(uw), u1 = bfhi(uw);
            float s0 = 0.f, s1 = 0.f;
            if (r < NCTX) { const int t = r & 255; if (t > 0) s0 = bf2f(ur[-1024]); if (t < 255) s1 = bf2f(ur[1024 + 1]); }
            else { const int t = (r - NCTX) & 4095, gx = t & 63, gy = t >> 6;
                if ((cp & 3) == 0) { if (gx > 0) s0 = bf2f(ur[-1024]); if (gx < 63) s1 = bf2f(ur[1024 + 1]); }
                else { if (gy > 0) s0 = bf2f(ur[-64 * 1024]); if (gy < 63) s1 = bf2f(ur[64 * 1024 + 1]); } }
            float m0 = u0 + (s0 - u0) * mu[cp], m1 = u1 + (s1 - u1) * mu[cp + 1];
            if (cp >= 768 && cp < 832) { m0 = tanhf_(m0); m1 = tanhf_(m1); }
            else if (cp >= 896) { m0 = sigmoidf_(m0); m1 = sigmoidf_(m1); }
            um[tk * 960 + cp] = m0; um[tk * 960 + cp + 1] = m1;
        }
        __syncthreads();
        for (int pr = wid; pr < 64; pr += 8) { const int tk = pr >> 2, hh = pr & 3; const float v = um[tk * 960 + 256 + hh * 64 + lane] * p.in[26][l * 256 + hh * 64 + lane];
            const float s = wave_sum(v * v); if (lane == 0) rs[pr] = rsqrtf(s + 1e-12f); }
        __syncthreads();
        for (int j = 0; j < 8; ++j) { const int tk = half * 8 + j; bf16_t* pr = P + (size_t)(r0 + tk) * 2048; const float kv = um[tk * 960 + 256 + c];
            pr[c] = f2bf(um[tk * 960 + c]); pr[256 + c] = f2bf(kv); pr[512 + c] = f2bf(um[tk * 960 + 512 + c]); pr[768 + c] = f2bf(kv * kkc * rs[tk * 4 + (c >> 6)]); }
#pragma unroll 1
        for (int mtx = 0; mtx < 5; ++mtx) {
            const int d = mtx & 1, isA = mtx >> 1;
            const float* Wm = (isA == 0 ? p.in[22] + (size_t)(l * 2 + d) * 32 * 256 : isA == 1 ? p.in[24] + (size_t)(l * 2 + d) * 32 * 256 : p.in[25] + (size_t)l * 64 * 256) + c;
            const float bias = isA == 0 ? p.in[21][(l * 2 + d) * 256 + c] : isA == 1 ? p.in[23][(l * 2 + d) * 256 + c] : 0.f;
            const int xoff = isA == 0 ? 768 + d * 32 : isA == 1 ? 832 + d * 32 : 896, nr4 = isA == 2 ? 16 : 8;
            float acc[8];
#pragma unroll
            for (int j = 0; j < 8; ++j) acc[j] = bias;
#pragma unroll 1
            for (int r4 = 0; r4 < nr4; ++r4) {
                const float w0 = Wm[(r4 * 4) * 256], w1 = Wm[(r4 * 4 + 1) * 256], w2 = Wm[(r4 * 4 + 2) * 256], w3 = Wm[(r4 * 4 + 3) * 256];
#pragma unroll
                for (int j = 0; j < 8; ++j) { const f32x4 x = *(const f32x4*)(um + (half * 8 + j) * 960 + xoff + r4 * 4); acc[j] += w0 * x.x + w1 * x.y + w2 * x.z + w3 * x.w; }
            }
#pragma unroll
            for (int j = 0; j < 8; ++j) { const size_t row = (size_t)(r0 + half * 8 + j);
                if (isA == 0) { const float wl = -softplusf_(-acc[j]) - 0.5f; const float e = __expf(wl); P[row * 2048 + 1536 + d * 256 + c] = f2bf(-expm1f(-e)); }
                else if (isA == 1) P[row * 2048 + 1024 + d * 256 + c] = f2bf(sigmoidf_(acc[j]));
                else G[row * 256 + c] = f2bf(acc[j]); }
        }
        __syncthreads();
    }
}

__device__ void scan_rwkv(const Params& p, int l, LAS float* lds) {
    constexpr int REC = 388, SLAB = 32;
    const int tid = otid(), wid = __builtin_amdgcn_readfirstlane(tid >> 6), lane = tid & 63, l16 = lane & 15;
    const bf16_t* P = (const bf16_t*)(p.ws + OFF_PR);
    bf16_t* O = (bf16_t*)(p.ws + OFF_OR);
    for (int u = blockIdx.x; u < 1280; u += gridDim.x) {
        const bool lat = u < 256; const int uu = lat ? u : u - 256;
        const int q = uu & 3, d = (uu >> 2) & 1, h = (uu >> 3) & 3, b = uu >> 5;
        const int base = lat ? NCTX + b * 4096 : b * 256, T = lat ? 4096 : 256, nslab = T / SLAB;
        const int irow = q * 16 + (wid & 3) * 4 + (lane >> 4);
        f32x4 s = {0.f, 0.f, 0.f, 0.f};
        if (wid < 4 && lat) s = *(const f32x4*)(p.in[3] + ((size_t)(((b * 2 + l) * 2 + d) * 4 + h) * 64 + irow) * 64 + l16 * 4);
        const float ka = p.in[27][l * 256 + h * 64 + lane], rk1 = 1.f + p.in[28][l * 256 + h * 64 + lane];
        auto produce = [&](int sl) {
            const int pw = wid - 4;
#pragma unroll
            for (int j = 0; j < 8; ++j) {
                const int js = pw * 8 + j, step = sl * SLAB + js, t = d ? T - 1 - step : step;
                const bf16_t* pr = P + (size_t)(base + t) * 2048 + h * 64 + lane;
                const float r = bf2f(pr[0]), k = bf2f(pr[256]), v = bf2f(pr[512]), kk = bf2f(pr[768]), a = bf2f(pr[1024 + d * 256]), omw = bf2f(pr[1536 + d * 256]);
                const float w = 1.f - omw, bb = a * kk, kd = k * (1.f + (a - 1.f) * ka), wr = w * r;
                const float br = wave_sum(bb * r), c1 = wave_sum(kd * r * rk1);
                LAS float* rec = lds + ((sl & 1) * SLAB + js) * REC;
                rec[lane] = w; rec[64 + lane] = bb; rec[128 + lane] = kd; rec[192 + lane] = kk; rec[256 + lane] = wr; rec[320 + lane] = v;
                if (lane == 0) { rec[384] = br; rec[385] = c1; }
            }
        };
        if (wid >= 4) produce(0);
        __syncthreads();
        for (int sl = 0; sl < nslab; ++sl) {
            if (wid >= 4) { if (sl + 1 < nslab) produce(sl + 1); }
            else {
#pragma unroll 4
                for (int j = 0; j < SLAB; ++j) {
                    const LAS float* rec = lds + ((sl & 1) * SLAB + j) * REC;
                    const f32x4 w4 = *(const LAS f32x4*)(rec + 4 * l16), b4 = *(const LAS f32x4*)(rec + 64 + 4 * l16), kd4 = *(const LAS f32x4*)(rec + 128 + 4 * l16),
                                kk4 = *(const LAS f32x4*)(rec + 192 + 4 * l16), wr4 = *(const LAS f32x4*)(rec + 256 + 4 * l16);
                    const float vi = rec[320 + irow], br = rec[384], c1 = rec[385];
                    float p1 = s.x * kk4.x + s.y * kk4.y + s.z * kk4.z + s.w * kk4.w;
                    float p2 = s.x * wr4.x + s.y * wr4.y + s.z * wr4.z + s.w * wr4.w;
                    p1 = row_allreduce<16>(p1); p2 = row_allreduce<16>(p2);
                    const float y = p2 - p1 * br + vi * c1;
                    s = s * w4 - p1 * b4 + vi * kd4;
                    const int step = sl * SLAB + j, t = d ? T - 1 - step : step;
                    if (l16 == 0) O[(size_t)(base + t) * 512 + d * 256 + h * 64 + irow] = f2bf(y);
                }
            }
            __syncthreads();
        }
        if (wid < 4 && !lat) *(f32x4*)(p.out + OS_RWKV + ((size_t)(((b * 2 + l) * 2 + d) * 4 + h) * 64 + irow) * 64 + l16 * 4) = s;
    }
}

__device__ void prep_ssd(const Params& p, int l) {
    const int lane = otid() & 63, gw = blockIdx.x * 8 + __builtin_amdgcn_readfirstlane(otid() >> 6), nw = gridDim.x * 8;
    const bf16_t* U = (const bf16_t*)(p.ws + OFF_US);
    bf16_t* P = (bf16_t*)(p.ws + OFF_PS); bf16_t* Z = (bf16_t*)(p.ws + OFF_ZS); float* DT = (float*)(p.ws + OFF_DT);
    const float* cw = p.in[14] + l * 3 * 768; const float* cb = p.in[15] + l * 768;
    for (int r = gw; r < MT; r += nw) {
        int t, T; if (r < NCTX) { t = r & 255; T = 256; } else { t = (r - NCTX) & 4095; T = 4096; }
        const bool hp = t > 0, hn = t < T - 1;
        const bf16_t* ur = U + (size_t)r * 1536;
#pragma unroll
        for (int j = 0; j < 6; ++j) {
            const int cp = 2 * (lane + 64 * j);
            const unsigned cu = *(const unsigned*)(ur + 512 + cp), pu = hp ? *(const unsigned*)(ur - 1536 + 512 + cp) : 0u, nu = hn ? *(const unsigned*)(ur + 1536 + 512 + cp) : 0u;
            const float a0 = cb[cp] + cw[cp] * bflo(pu) + cw[768 + cp] * bflo(cu) + cw[1536 + cp] * bflo(nu);
            const float a1 = cb[cp + 1] + cw[cp + 1] * bfhi(pu) + cw[768 + cp + 1] * bfhi(cu) + cw[1536 + cp + 1] * bfhi(nu);
            *(unsigned*)(P + (size_t)r * 768 + cp) = pk2(siluf_(a0), siluf_(a1));
        }
#pragma unroll
        for (int j = 0; j < 4; ++j) { const int cp = 2 * (lane + 64 * j); const unsigned zu = *(const unsigned*)(ur + cp); *(unsigned*)(Z + (size_t)r * 512 + cp) = pk2(siluf_(bflo(zu)), siluf_(bfhi(zu))); }
        if (lane < 16) { const float raw = bf2f(ur[1280 + lane]); const float dt = softplusf_(raw + p.in[16][l * 16 + lane]); const float a = -__expf(p.in[17][l * 16 + lane]);
            DT[(size_t)r * 32 + lane] = dt; DT[(size_t)r * 32 + 16 + lane] = __expf(dt * a); }
    }
}
__device__ void scan_ssd(const Params& p, int l, LAS float* lds) {
    constexpr int REC = 196, SLAB = 32;
    const int tid = otid(), wid = __builtin_amdgcn_readfirstlane(tid >> 6), lane = tid & 63, l8 = lane & 7;
    const bf16_t* P = (const bf16_t*)(p.ws + OFF_PS); const float* DT = (const float*)(p.ws + OFF_DT);
    bf16_t* O = (bf16_t*)(p.ws + OFF_OS);
    for (int u = blockIdx.x; u < 1280; u += gridDim.x) {
        const bool lat = u < 256; const int uu = lat ? u : u - 256;
        const int hf = uu & 1, d = (uu >> 1) & 1, h = (uu >> 2) & 7, b = uu >> 5, g = h >> 2;
        const int base = lat ? NCTX + b * 4096 : b * 256, T = lat ? 4096 : 256, nslab = T / SLAB;
        const int prow = hf * 32 + (wid & 3) * 8 + (lane >> 3);
        f32x4 sa = {0.f, 0.f, 0.f, 0.f}, sb = {0.f, 0.f, 0.f, 0.f};
        if (wid < 4 && lat) { const float* sp = p.in[2] + ((size_t)(((b * 2 + l) * 2 + d) * 8 + h) * 64 + prow) * 64 + l8 * 8; sa = *(const f32x4*)sp; sb = *(const f32x4*)(sp + 4); }
        const float dsk = d == 0 ? p.in[18][l * 8 + h] : 0.f;
        auto produce = [&](int sl) {
            const int pw = wid - 4;
#pragma unroll
            for (int j = 0; j < 8; ++j) {
                const int js = pw * 8 + j, step = sl * SLAB + js, t = d ? T - 1 - step : step;
                const size_t row = (size_t)(base + t);
                const bf16_t* pr = P + row * 768;
                LAS float* rec = lds + ((sl & 1) * SLAB + js) * REC;
                rec[lane] = bf2f(pr[512 + g * 64 + lane]); rec[64 + lane] = bf2f(pr[640 + g * 64 + lane]); rec[128 + lane] = bf2f(pr[h * 64 + lane]);
                if (lane == 0) { rec[192] = DT[row * 32 + d * 8 + h]; rec[193] = DT[row * 32 + 16 + d * 8 + h]; }
            }
        };
        if (wid >= 4) produce(0);
        __syncthreads();
        for (int sl = 0; sl < nslab; ++sl) {
            if (wid >= 4) { if (sl + 1 < nslab) produce(sl + 1); }
            else {
#pragma unroll 4
                for (int j = 0; j < SLAB; ++j) {
                    const LAS float* rec = lds + ((sl & 1) * SLAB + j) * REC;
                    const f32x4 B0 = *(const LAS f32x4*)(rec + 8 * l8), B1 = *(const LAS f32x4*)(rec + 8 * l8 + 4), C0 = *(const LAS f32x4*)(rec + 64 + 8 * l8), C1 = *(const LAS f32x4*)(rec + 64 + 8 * l8 + 4);
                    const float xp = rec[128 + prow], dt = rec[192], e = rec[193];
                    const float xd = xp * dt;
                    sa = sa * e + xd * B0; sb = sb * e + xd * B1;
                    float y = sa.x * C0.x + sa.y * C0.y + sa.z * C0.z + sa.w * C0.w + sb.x * C1.x + sb.y * C1.y + sb.z * C1.z + sb.w * C1.w;
                    y = row_allreduce<8>(y) + dsk * xp;
                    const int step = sl * SLAB + j, t = d ? T - 1 - step : step;
                    if (l8 == 0) O[(size_t)(base + t) * 1024 + d * 512 + h * 64 + prow] = f2bf(y);
                }
            }
            __syncthreads();
        }
        if (wid < 4 && !lat) { float* sp = p.out + OS_SSD + ((size_t)(((b * 2 + l) * 2 + d) * 8 + h) * 64 + prow) * 64 + l8 * 8; *(f32x4*)sp = sa; *(f32x4*)(sp + 4) = sb; }
    }
}

__device__ void prep_mlstm(const Params& p, int l) {
    const int lane = otid() & 63, gw = blockIdx.x * 8 + __builtin_amdgcn_readfirstlane(otid() >> 6), nw = gridDim.x * 8;
    const bf16_t* U = (const bf16_t*)(p.ws + OFF_UM);
    bf16_t* P = (bf16_t*)(p.ws + OFF_PM); float* GM = (float*)(p.ws + OFF_GM);
    const float* cw = p.in[30] + l * 3 * 512; const float* cb = p.in[31] + l * 512;
    for (int r = gw; r < MT; r += nw) {
        int t, T; if (r < NCTX) { t = r & 255; T = 256; } else { t = (r - NCTX) & 4095; T = 4096; }
        const bool hp = t > 0, hn = t < T - 1;
        const bf16_t* ur = U + (size_t)r * 1280;
#pragma unroll
        for (int j = 0; j < 4; ++j) {
            const int cp = 2 * (lane + 64 * j);
            const unsigned cu = *(const unsigned*)(ur + cp), pu = hp ? *(const unsigned*)(ur - 1280 + cp) : 0u, nu = hn ? *(const unsigned*)(ur + 1280 + cp) : 0u;
            const float a0 = cb[cp] + cw[cp] * bflo(pu) + cw[512 + cp] * bflo(cu) + cw[1024 + cp] * bflo(nu);
            const float a1 = cb[cp + 1] + cw[cp + 1] * bfhi(pu) + cw[512 + cp + 1] * bfhi(cu) + cw[1024 + cp + 1] * bfhi(nu);
            const float sc = cp >= 256 ? 0.125f : 1.f;
            *(unsigned*)(P + (size_t)r * 512 + cp) = pk2(siluf_(a0) * sc, siluf_(a1) * sc);
        }
        if (lane < 16) { const int d = lane >> 3, gi = (lane >> 2) & 1, hh = lane & 3; const float raw = bf2f(ur[1024 + lane]);
            if (gi == 0) GM[(size_t)r * 16 + d * 8 + hh] = raw + p.in[32][(l * 2 + d) * 4 + hh];
            else GM[(size_t)r * 16 + d * 8 + 4 + hh] = -softplusf_(-(raw + p.in[33][(l * 2 + d) * 4 + hh])); }
    }
}
__device__ void scan_mlstm(const Params& p, int l, LAS float* lds) {
    constexpr int REC = 196, SLAB = 32;
    const int tid = otid(), wid = __builtin_amdgcn_readfirstlane(tid >> 6), lane = tid & 63, l16 = lane & 15;
    const bf16_t* P = (const bf16_t*)(p.ws + OFF_PM); const bf16_t* U = (const bf16_t*)(p.ws + OFF_UM); const float* GM = (const float*)(p.ws + OFF_GM);
    bf16_t* O = (bf16_t*)(p.ws + OFF_OM);
    for (int u = blockIdx.x; u < 1280; u += gridDim.x) {
        const bool lat = u < 256; const int uu = lat ? u : u - 256;
        const int q = uu & 3, d = (uu >> 2) & 1, h = (uu >> 3) & 3, b = uu >> 5;
        const int base = lat ? NCTX + b * 4096 : b * 256, T = lat ? 4096 : 256, nslab = T / SLAB;
        const int irow = q * 16 + (wid & 3) * 4 + (lane >> 4);
        const int sidx = ((b * 2 + l) * 2 + d) * 4 + h;
        f32x4 s = {0.f, 0.f, 0.f, 0.f};
        if (wid < 4 && lat) s = *(const f32x4*)(p.in[4] + ((size_t)sidx * 64 + irow) * 64 + l16 * 4);
        float nst = 0.f, mst = 0.f;
        if (wid == 4 && lat) { nst = p.in[5][sidx * 64 + lane]; mst = p.in[6][sidx]; }
        auto produce = [&](int sl) {
            if (wid == 4) {
#pragma unroll 4
                for (int js = 0; js < SLAB; ++js) {
                    const int step = sl * SLAB + js, t = d ? T - 1 - step : step;
                    const size_t row = (size_t)(base + t);
                    const float qv = bf2f(P[row * 512 + h * 64 + lane]), kv = bf2f(P[row * 512 + 256 + h * 64 + lane]);
                    const float ig = GM[row * 16 + d * 8 + h], lf = GM[row * 16 + d * 8 + 4 + h];
                    const float mn = fmaxf(lf + mst, ig), ff = __expf(lf + mst - mn), ii = __expf(ig - mn);
                    nst = ff * nst + ii * kv; mst = mn;
                    const float den = wave_sum(nst * qv);
                    const float inv = 1.f / fmaxf(fabsf(den), __expf(-mn));
                    LAS float* rec = lds + ((sl & 1) * SLAB + js) * REC;
                    if (lane == 0) { rec[192] = ff; rec[193] = ii; rec[194] = inv; }
                }
            } else {
                for (int js = wid - 5; js < SLAB; js += 3) {
                    const int step = sl * SLAB + js, t = d ? T - 1 - step : step;
                    const size_t row = (size_t)(base + t);
                    LAS float* rec = lds + ((sl & 1) * SLAB + js) * REC;
                    rec[lane] = bf2f(P[row * 512 + h * 64 + lane]); rec[64 + lane] = bf2f(P[row * 512 + 256 + h * 64 + lane]); rec[128 + lane] = bf2f(U[row * 1280 + 512 + h * 64 + lane]);
                }
            }
        };
        if (wid >= 4) produce(0);
        __syncthreads();
        for (int sl = 0; sl < nslab; ++sl) {
            if (wid >= 4) { if (sl + 1 < nslab) produce(sl + 1); }
            else {
#pragma unroll 4
                for (int j = 0; j < SLAB; ++j) {
                    const LAS float* rec = lds + ((sl & 1) * SLAB + j) * REC;
                    const f32x4 q4 = *(const LAS f32x4*)(rec + 4 * l16), k4 = *(const LAS f32x4*)(rec + 64 + 4 * l16);
                    const float vi = rec[128 + irow], ff = rec[192], ii = rec[193], inv = rec[194];
                    s = s * ff + (ii * vi) * k4;
                    float num = s.x * q4.x + s.y * q4.y + s.z * q4.z + s.w * q4.w;
                    num = row_allreduce<16>(num);
                    const int step = sl * SLAB + j, t = d ? T - 1 - step : step;
                    if (l16 == 0) O[(size_t)(base + t) * 512 + d * 256 + h * 64 + irow] = f2bf(num * inv);
                }
            }
            __syncthreads();
        }
        if (!lat) {
            if (wid < 4) *(f32x4*)(p.out + OS_MC + ((size_t)sidx * 64 + irow) * 64 + l16 * 4) = s;
            if (wid == 4 && q == 0) { p.out[OS_MN + (size_t)sidx * 64 + lane] = nst; if (lane == 0) p.out[OS_MM + sidx] = mst; }
        }
    }
}

__device__ void post_phase(const Params& p, int l) {
    const int lane = otid() & 63, gw = blockIdx.x * 8 + __builtin_amdgcn_readfirstlane(otid() >> 6), nw = gridDim.x * 8;
    const bf16_t* OS = (const bf16_t*)(p.ws + OFF_OS); const bf16_t* ZS = (const bf16_t*)(p.ws + OFF_ZS);
    const bf16_t* OR_ = (const bf16_t*)(p.ws + OFF_OR); const bf16_t* GR = (const bf16_t*)(p.ws + OFF_GR);
    const bf16_t* OM = (const bf16_t*)(p.ws + OFF_OM); const bf16_t* UM = (const bf16_t*)(p.ws + OFF_UM);
    bf16_t* Y = (bf16_t*)(p.ws + OFF_H);
    const float* gs = p.in[19] + l * 512; const float* gr = p.in[29] + l * 256; const float* gm = p.in[34] + l * 256;
    for (int r = gw; r < MT; r += nw) {
        {
            const int c = lane * 8;
            const u32x4 yf = *(const u32x4*)(OS + (size_t)r * 1024 + c), yb = *(const u32x4*)(OS + (size_t)r * 1024 + 512 + c), zz = *(const u32x4*)(ZS + (size_t)r * 512 + c);
            float y[8];
#pragma unroll
            for (int j = 0; j < 4; ++j) { y[2 * j] = (bflo(yf[j]) + bflo(yb[j])) * bflo(zz[j]); y[2 * j + 1] = (bfhi(yf[j]) + bfhi(yb[j])) * bfhi(zz[j]); }
            float ss = 0.f;
#pragma unroll
            for (int j = 0; j < 8; ++j) ss += y[j] * y[j];
#pragma unroll
            for (int o = 1; o < 32; o <<= 1) ss += __shfl_xor(ss, o);
            const float rstd = rsqrtf(ss * (1.f / 256.f) + 1e-5f);
            u32x4 w;
#pragma unroll
            for (int j = 0; j < 4; ++j) w[j] = pk2(y[2 * j] * rstd * gs[c + 2 * j], y[2 * j + 1] * rstd * gs[c + 2 * j + 1]);
            *(u32x4*)(Y + (size_t)r * 1024 + c) = w;
        }
#pragma unroll
        for (int mx = 0; mx < 2; ++mx) {
            const int c = lane * 4;
            const bf16_t* Ob = mx == 0 ? OR_ : OM;
            const u32x2 of = *(const u32x2*)(Ob + (size_t)r * 512 + c), ob = *(const u32x2*)(Ob + (size_t)r * 512 + 256 + c);
            float v[4] = {bflo(of.x) + bflo(ob.x), bfhi(of.x) + bfhi(ob.x), bflo(of.y) + bflo(ob.y), bfhi(of.y) + bfhi(ob.y)};
            float sm_ = v[0] + v[1] + v[2] + v[3];
#pragma unroll
            for (int o = 1; o < 16; o <<= 1) sm_ += __shfl_xor(sm_, o);
            const float mean = sm_ * (1.f / 64.f);
            float ss = 0.f;
#pragma unroll
            for (int j = 0; j < 4; ++j) { v[j] -= mean; ss += v[j] * v[j]; }
#pragma unroll
            for (int o = 1; o < 16; o <<= 1) ss += __shfl_xor(ss, o);
            const float rstd = rsqrtf(ss * (1.f / 64.f) + 1e-5f);
            const float* gg = mx == 0 ? gr : gm;
            float gt[4];
            if (mx == 0) { const u32x2 gv = *(const u32x2*)(GR + (size_t)r * 256 + c); gt[0] = bflo(gv.x); gt[1] = bfhi(gv.x); gt[2] = bflo(gv.y); gt[3] = bfhi(gv.y); }
            else { const u32x2 ov = *(const u32x2*)(UM + (size_t)r * 1280 + 768 + c); gt[0] = sigmoidf_(bflo(ov.x)); gt[1] = sigmoidf_(bfhi(ov.x)); gt[2] = sigmoidf_(bflo(ov.y)); gt[3] = sigmoidf_(bfhi(ov.y)); }
            u32x2 w; w.x = pk2(v[0] * rstd * gg[c] * gt[0], v[1] * rstd * gg[c + 1] * gt[1]); w.y = pk2(v[2] * rstd * gg[c + 2] * gt[2], v[3] * rstd * gg[c + 3] * gt[3]);
            *(u32x2*)(Y + (size_t)r * 1024 + 512 + mx * 256 + c) = w;
        }
    }
}

constexpr int NPHASE = 32;
__device__ void run_phase(const Params& p, int ph, unsigned char* shm) {
    LAS unsigned char* lds = (LAS unsigned char*)shm;
    if (ph == 0) { prologue_phase(p, (float*)shm); return; }
    if (ph == NPHASE - 1) { final_norm_phase(p); return; }
    const int l = (ph - 1) / 15, sub = (ph - 1) % 15;
    const bf16_t* H = (const bf16_t*)(p.ws + OFF_H);
    const float* modl = (const float*)(p.ws + OFF_MOD) + (size_t)l * 9 * 6144;
    switch (sub) {
    case 0: norm_phase(p, l, 0); break;
    case 1: case 4: case 7: {
        const bf16_t* Bt = sub == 1 ? (const bf16_t*)(p.ws + OFF_WR) + (size_t)l * NR * 1024 : sub == 4 ? (const bf16_t*)(p.ws + OFF_WS) + (size_t)l * NS * 1024 : (const bf16_t*)(p.ws + OFF_WM) + (size_t)l * NM * 1024;
        const int N = sub == 1 ? NR : sub == 4 ? NS : NM;
        EpiStoreBf16 E{(bf16_t*)(p.ws + (sub == 1 ? OFF_UR : sub == 4 ? OFF_US : OFF_UM)), N};
        run_gemm(lds, H, Bt, N, 1024, E); } break;
    case 2: prep_rwkv(p, l, (float*)shm); break;
    case 3: scan_rwkv(p, l, (LAS float*)lds); break;
    case 5: prep_ssd(p, l); break;
    case 6: scan_ssd(p, l, (LAS float*)lds); break;
    case 8: prep_mlstm(p, l); break;
    case 9: scan_mlstm(p, l, (LAS float*)lds); break;
    case 10: post_phase(p, l); break;
    case 11: case 14: {
        const bool ffn = sub == 14;
        EpiResidual E{p.in[0], p.in[1], (!ffn && l == 0) ? 1 : 0, p.out, modl + (ffn ? 5120 : 2048)};
        const bf16_t* A = ffn ? (const bf16_t*)(p.ws + OFF_ACT) : H;
        const bf16_t* Bt = ffn ? (const bf16_t*)(p.ws + OFF_W2) + (size_t)l * 1024 * 2816 : (const bf16_t*)(p.ws + OFF_WO) + (size_t)l * 1024 * 1024;
        run_gemm(lds, A, Bt, 1024, ffn ? 2816 : 1024, E); } break;
    case 12: norm_phase(p, l, 1); break;
    case 13: { EpiSwiglu E{(bf16_t*)(p.ws + OFF_ACT)}; run_gemm(lds, H, (const bf16_t*)(p.ws + OFF_W13) + (size_t)l * 5632 * 1024, 5632, 1024, E); } break;
    }
}
__global__ __launch_bounds__(512, 2) void mega(Params p) {
    extern __shared__ __attribute__((aligned(16))) unsigned char shm[];
    cg::grid_group grid = cg::this_grid();
    for (int ph = p.ph_lo; ph < p.ph_hi; ++ph) {
        if (ph > p.ph_lo) grid.sync();
        run_phase(p, ph, shm);
    }
}
}

extern "C" void kernel_launch(void* const* d_in, const int* in_sizes, int n_in, void* d_out, int out_size, void* d_ws, size_t ws_size, hipStream_t stream) {
    static int grid = 0;
    if (grid == 0) {
        if (n_in != 40 || ws_size < mk::WS_END) { fprintf(stderr, "kernel_launch: need 40 inputs and %zu bytes of workspace (got %d, %zu)\n", (size_t)mk::WS_END, n_in, ws_size); grid = -1; return; }
        int dev = 0, cus = 0, per_cu = 0;
        hipGetDevice(&dev); hipDeviceGetAttribute(&cus, hipDeviceAttributeMultiprocessorCount, dev);
        if (hipFuncSetAttribute((const void*)mk::mega, hipFuncAttributeMaxDynamicSharedMemorySize, mk::LDS_BYTES) != hipSuccess) { fprintf(stderr, "kernel_launch: hipFuncSetAttribute failed\n"); }
        if (hipOccupancyMaxActiveBlocksPerMultiprocessor(&per_cu, (const void*)mk::mega, 512, mk::LDS_BYTES) != hipSuccess || per_cu < 1) per_cu = 1;
        (void)hipGetLastError();
        grid = cus * 1;
    }
    if (grid < 0) return;
    mk::Params p{};
    for (int i = 0; i < 40; ++i) p.in[i] = (const float*)d_in[i];
    p.out = (float*)d_out; p.ws = (unsigned char*)d_ws;
#if ONE_LAUNCH
    p.ph_lo = 0; p.ph_hi = mk::NPHASE;
    void* args[] = {&p};
    hipError_t e = hipLaunchCooperativeKernel((const void*)mk::mega, dim3(grid), dim3(512), args, mk::LDS_BYTES, stream);
    if (e != hipSuccess) fprintf(stderr, "cooperative launch failed: %s (grid %d)\n", hipGetErrorString(e), grid);
#else
    for (int ph = 0; ph < mk::NPHASE; ++ph) {
        p.ph_lo = ph; p.ph_hi = ph + 1;
        hipLaunchKernelGGL(mk::mega, dim3(grid), dim3(512), mk::LDS_BYTES, stream, p);
    }
#endif
}
```

```cpp
#include <hip/hip_runtime.h>
#include <hip/hip_cooperative_groups.h>
#include <cstdio>
namespace cg = cooperative_groups;
#ifndef ONE_LAUNCH
#define ONE_LAUNCH 1
#endif
namespace pg8 {
#define PG8_LAS __attribute__((address_space(3)))
typedef unsigned short bf16_t;
typedef short bf16x8 __attribute__((ext_vector_type(8)));
typedef float f32x4 __attribute__((ext_vector_type(4)));
typedef unsigned u32x4 __attribute__((ext_vector_type(4)));
constexpr int BM = 256, BK = 64, HALF = 128, HTB = HALF * BK * 2  , STAGE_BYTES = 8 * HTB, NXCD = 8, WGM = 8;

__host__ __device__ __forceinline__ int lds_byte(int r, int c) { const int st = (r >> 4) * 2 + (c >> 5), rr = r & 15, cc = c & 31, ob = rr * 64 + cc * 2; return st * 1024 + (ob ^ (((ob >> 9) & 1) << 5)); }
__host__ __device__ __forceinline__ void stage_rc(int b, int& R, int& C) { const int st = b / 1024, sb = b % 1024, swz = sb ^ (((sb >> 9) & 1) << 5); R = (st >> 1) * 16 + swz / 64; C = (st & 1) * 32 + (swz % 64) / 2; }
__host__ __device__ __forceinline__ int perm32(int rho) { const int n = rho >> 4, i = rho & 15; return 8 * (i >> 2) + 4 * n + (i & 3); }

struct Unit { int pm, pn; };
struct Gemm { const bf16_t* A; const bf16_t* Bt; int M, N, K; };

struct StaticOrder {
    int nM, nN, nwg, G, c;
    __host__ __device__ void init(int M, int N, int G_, int c_) { nM = M / BM; nN = N / BM; nwg = nM * nN; G = G_; c = c_; }
    __host__ __device__ bool next(int i, Unit& u) const {
        const long L = (long)i * G + c; if (L >= nwg) return false;
        int wgid = (int)L; { const int q = nwg / NXCD, r = nwg % NXCD, xcd = wgid % NXCD, off = wgid / NXCD; wgid = (xcd < r ? xcd * (q + 1) : r * (q + 1) + (xcd - r) * q) + off; }
        const int nig = WGM * nN, gid = wgid / nig, fm = gid * WGM, gsz = (nM - fm) < WGM ? (nM - fm) : WGM;
        u.pm = fm + ((wgid % nig) % gsz); u.pn = (wgid % nig) / gsz; return true;
    }
    __device__ __forceinline__ void a_ready(const Unit&) const {}
    __device__ __forceinline__ void done(const Unit&) const {}
};
__device__ __forceinline__ unsigned cvt_pk_bf16(float lo, float hi) { unsigned r; asm volatile("v_cvt_pk_bf16_f32 %0, %1, %2" : "=v"(r) : "v"(lo), "v"(hi)); return r; }
template <class Epi, class Sched, bool STAMP = false>
__device__ __forceinline__ void gemm_phase(PG8_LAS unsigned char* lds, const Gemm g, const Sched& S, const Epi& E, unsigned long long* stamps) {
    int tid_l = threadIdx.x; asm volatile("" : "+v"(tid_l));
    const int tid = tid_l, wid = __builtin_amdgcn_readfirstlane(tid >> 6), lane = tid & 63, wr = wid >> 2, wc = wid & 3, fr = lane & 15, fq = lane >> 4;
    const int K = g.K, nt = K / BK;
    int ts_lo = 0, ts_hi = 0, nts = 0; const unsigned long long rt_entry = STAMP ? (unsigned long long)wall_clock64() : 0ull;
#define PG8_STAMP() do { if (STAMP && wid == 0 && nts < 64) { const unsigned long long _c = (unsigned long long)clock64(); \
        ts_lo = (lane == nts) ? (int)(unsigned)_c : ts_lo; ts_hi = (lane == nts) ? (int)(unsigned)(_c >> 32) : ts_hi; ++nts; } } while (0)
    PG8_STAMP();
    unsigned voffA[2], voffB[2];
#pragma unroll
    for (int i = 0; i < 2; ++i) { int R, C; stage_rc(tid * 16 + i * 8192, R, C); const int Rb = Epi::PERM ? ((R & ~31) + perm32(R & 31)) : R;
        voffA[i] = (unsigned)(R * K + C) * 2u; voffB[i] = (unsigned)(Rb * K + C) * 2u; }
    const size_t kstep = (size_t)(BK * 2);
    const size_t hstep = (size_t)HALF * K * 2;
    const size_t tstep = 2 * hstep;
    const unsigned ldsw = (unsigned)wid * 1024u;
    const int aoff = lds_byte(wr * 64 + fr, fq * 8), boff = lds_byte(wc * 32 + fr, fq * 8);
#define PG8_SA(b, h) (((b) * 2 + (h)) * HTB)
#define PG8_SB(b, h) ((4 + (b) * 2 + (h)) * HTB)
#define PG8_STAGE(bufoff, gbase, voff) do { _Pragma("unroll") for (int _i = 0; _i < 2; ++_i) \
        __builtin_amdgcn_global_load_lds((const unsigned*)((const char*)(gbase) + (voff)[_i]), (PG8_LAS unsigned*)(lds + (bufoff) + ldsw + _i * 8192), 16, 0, 0); } while (0)
#define PG8_LDA(dst, b, h) do { _Pragma("unroll") for (int m = 0; m < 4; ++m) _Pragma("unroll") for (int k = 0; k < 2; ++k) dst[m][k] = *(const PG8_LAS bf16x8*)(lds + PG8_SA(b, h) + aoff + m * 2048 + k * 1024); } while (0)
#define PG8_LDB(dst, b, h) do { _Pragma("unroll") for (int n = 0; n < 2; ++n) _Pragma("unroll") for (int k = 0; k < 2; ++k) dst[n][k] = *(const PG8_LAS bf16x8*)(lds + PG8_SB(b, h) + boff + n * 2048 + k * 1024); } while (0)
#define PG8_MMA(ai, bj, At, Bt) do { __builtin_amdgcn_s_setprio(1); _Pragma("unroll") for (int m = 0; m < 4; ++m) _Pragma("unroll") for (int n = 0; n < 2; ++n) _Pragma("unroll") for (int k = 0; k < 2; ++k) \
        acc[ai][bj][m][n] = __builtin_amdgcn_mfma_f32_16x16x32_bf16(Bt[n][k], At[m][k], acc[ai][bj][m][n], 0, 0, 0); __builtin_amdgcn_s_setprio(0); } while (0)
#define PG8_WAIT_V(n) asm volatile("s_waitcnt vmcnt(" #n ")" ::: "memory")
#define PG8_WAIT_L(n) asm volatile("s_waitcnt lgkmcnt(" #n ")" ::: "memory")
#define PG8_BAR __builtin_amdgcn_s_barrier()
#define PG8_SCHED __builtin_amdgcn_sched_barrier(0)
    Unit cur, nxt; int ui = 0;
    if (!S.next(0, cur)) return;
    f32x4 acc[2][2][4][2];
#pragma unroll
    for (int a = 0; a < 2; ++a)
#pragma unroll
        for (int b = 0; b < 2; ++b)
#pragma unroll
            for (int m = 0; m < 4; ++m)
#pragma unroll
                for (int n = 0; n < 2; ++n) acc[a][b][m][n] = (f32x4){0.f, 0.f, 0.f, 0.f};
    bf16x8 At[4][2], B0[2][2], B1[2][2];
    const char* cA = (const char*)g.A + (size_t)cur.pm * tstep; const char* cB = (const char*)g.Bt + (size_t)cur.pn * tstep;
    S.a_ready(cur);
    PG8_STAGE(PG8_SB(0, 0), cB, voffB); PG8_STAGE(PG8_SA(0, 0), cA, voffA); PG8_STAGE(PG8_SB(0, 1), cB + hstep, voffB); PG8_STAGE(PG8_SA(0, 1), cA + hstep, voffA);
    if (wr == 1) PG8_BAR;
    PG8_WAIT_V(4); PG8_BAR;
    PG8_STAGE(PG8_SB(1, 0), cB + kstep, voffB); PG8_STAGE(PG8_SA(1, 0), cA + kstep, voffA); PG8_STAGE(PG8_SB(1, 1), cB + hstep + kstep, voffB);
    PG8_WAIT_V(6); PG8_BAR;
    PG8_STAMP();
    for (;;) {
        const bool has_next = S.next(ui + 1, nxt);
        const char* nA = has_next ? (const char*)g.A + (size_t)nxt.pm * tstep : cA; const char* nB = has_next ? (const char*)g.Bt + (size_t)nxt.pn * tstep : cB;
        for (int t = 0; t < nt; t += 2) {
            const bool last = (t == nt - 2);
            const char* a1 = cA + (size_t)(t + 1) * kstep;
            const char* a2 = last ? nA : cA + (size_t)(t + 2) * kstep; const char* b2 = last ? nB : cB + (size_t)(t + 2) * kstep;
            const char* a3 = a2 + kstep; const char* b3 = b2 + kstep;
            if (last && has_next) S.a_ready(nxt);
            PG8_LDB(B0, 0, 0); PG8_SCHED; PG8_LDA(At, 0, 0); PG8_STAGE(PG8_SA(1, 1), a1 + hstep, voffA);
            PG8_WAIT_L(8); PG8_BAR; PG8_WAIT_L(0); PG8_MMA(0, 0, At, B0); PG8_BAR; PG8_SCHED;
            PG8_LDB(B1, 0, 1); PG8_STAGE(PG8_SB(0, 0), b2, voffB);
            PG8_BAR; PG8_WAIT_L(0); PG8_MMA(0, 1, At, B1); PG8_BAR;
            PG8_LDA(At, 0, 1); PG8_STAGE(PG8_SA(0, 0), a2, voffA);
            PG8_BAR; PG8_WAIT_L(0); PG8_MMA(1, 0, At, B0); PG8_BAR; PG8_SCHED;
            PG8_STAGE(PG8_SB(0, 1), b2 + hstep, voffB);
            PG8_WAIT_V(6); PG8_BAR; PG8_MMA(1, 1, At, B1); PG8_BAR;
            PG8_LDB(B0, 1, 0); PG8_SCHED; PG8_LDA(At, 1, 0); PG8_STAGE(PG8_SA(0, 1), a2 + hstep, voffA);
            PG8_WAIT_L(8); PG8_BAR; PG8_WAIT_L(0); PG8_MMA(0, 0, At, B0); PG8_BAR; PG8_SCHED;
            PG8_LDB(B1, 1, 1); PG8_STAGE(PG8_SB(1, 0), b3, voffB);
            PG8_BAR; PG8_WAIT_L(0); PG8_MMA(0, 1, At, B1); PG8_BAR;
            PG8_LDA(At, 1, 1); PG8_STAGE(PG8_SA(1, 0), a3, voffA);
            PG8_BAR; PG8_WAIT_L(0); PG8_MMA(1, 0, At, B0); PG8_BAR; PG8_SCHED;
            PG8_STAGE(PG8_SB(1, 1), b3 + hstep, voffB);
            PG8_WAIT_V(6); PG8_BAR; PG8_MMA(1, 1, At, B1); PG8_BAR;
        }
        PG8_STAMP();
        if constexpr (!Epi::AFTER_DRAIN) { E(acc, cur, wr, wc, fr, fq); S.done(cur); }
        PG8_STAMP();
        if (!has_next) break;
#pragma unroll
        for (int a = 0; a < 2; ++a)
#pragma unroll
            for (int b = 0; b < 2; ++b)
#pragma unroll
                for (int m = 0; m < 4; ++m)
#pragma unroll
                    for (int n = 0; n < 2; ++n) acc[a][b][m][n] = (f32x4){0.f, 0.f, 0.f, 0.f};
        cur = nxt; cA = nA; cB = nB; ++ui;
    }
    PG8_WAIT_V(0);
    if (wr == 0) PG8_BAR;
    PG8_BAR;
    if constexpr (Epi::AFTER_DRAIN) { E.fused(acc, cur, wr, wc, fr, fq, lds, wid, lane); S.done(cur); }
    PG8_STAMP();
    if (STAMP && wid == 0) { stamps[lane] = lane < nts ? (((unsigned long long)(unsigned)ts_hi << 32) | (unsigned)ts_lo) : 0ull;
        if (lane == 62) stamps[62] = rt_entry; if (lane == 63) stamps[63] = (unsigned long long)wall_clock64(); }
#undef PG8_STAMP
#undef PG8_SA
#undef PG8_SB
#undef PG8_STAGE
#undef PG8_LDA
#undef PG8_LDB
#undef PG8_MMA
#undef PG8_WAIT_V
#undef PG8_WAIT_L
#undef PG8_BAR
#undef PG8_SCHED
}
}
#define XB_TMO      128
#define XB_XCNT(j)  (256  + 64 * (j))
#define XB_XSUB(j)  (1280 + 64 * (j))
#define XB_XGEN(j)  (2304 + 64 * (j))
#define XB_TOP      3328
#define XB_TOPGEN   3392
#define XCD_BAR_WORDS 3456
#define XB_SPIN_CAP (1u << 18)
#define LAS __attribute__((address_space(3)))

__device__ __forceinline__ unsigned xb_ld(unsigned* p)              { return __hip_atomic_load(p, __ATOMIC_RELAXED, __HIP_MEMORY_SCOPE_AGENT); }
__device__ __forceinline__ unsigned xb_add(unsigned* p, unsigned v) { return __hip_atomic_fetch_add(p, v, __ATOMIC_RELAXED, __HIP_MEMORY_SCOPE_AGENT); }
__device__ __forceinline__ unsigned xb_xcc_id() { return (unsigned)__builtin_amdgcn_s_getreg((3 << 11) | 20) & 0xFu; }
#define XB_SPIN(cond, bar) do { unsigned _sp = 0; while (cond) { __builtin_amdgcn_s_sleep(1); \
    if ((++_sp & 255u) == 0u) { if (xb_ld(&(bar)[XB_TMO])) break; if (_sp > XB_SPIN_CAP) { atomicAdd(&(bar)[XB_TMO], 1u); break; } } } } while (0)

struct XcdBarrier {
    unsigned* bar; unsigned x;
    volatile LAS unsigned* st;
};

__device__ __forceinline__ XcdBarrier xcd_barrier_post(unsigned* bar, volatile LAS unsigned* st) {
    XcdBarrier b; b.bar = bar; b.x = xb_xcc_id(); b.st = st;
    if (threadIdx.x == 0) (void)xb_add(&bar[XB_XCNT(b.x)], 1u);
    return b;
}
__device__ __forceinline__ void xcd_barrier_complete(unsigned* bar, unsigned x, unsigned& nloc, unsigned& nx) {
    const unsigned G = gridDim.x * gridDim.y * gridDim.z;
    unsigned sum, cnt, mine, sp = 0u;
    for (;;) {
        sum = 0u; cnt = 0u; mine = 0u;
#pragma unroll
        for (unsigned j = 0; j < 16; ++j) { const unsigned c = xb_ld(&bar[XB_XCNT(j)]); sum += c; cnt += (c > 0u) ? 1u : 0u; mine = (j == x) ? c : mine; }
        if (sum == G) break;
        __builtin_amdgcn_s_sleep(1);
        if ((++sp & 255u) == 0u) { if (xb_ld(&bar[XB_TMO])) break; if (sp > XB_SPIN_CAP) { atomicAdd(&bar[XB_TMO], 1u); break; } }
    }
    nloc = mine > 0u ? mine : 1u; nx = cnt > 0u ? cnt : 1u;
}

__device__ __forceinline__ void xcd_barrier(const XcdBarrier& b) {
    asm volatile("s_waitcnt vmcnt(0)" ::: "memory");
    __syncthreads();
    if (threadIdx.x == 0) {
        unsigned* bar = b.bar;
        __builtin_amdgcn_s_waitcnt(0);
        unsigned nloc = b.st[0], nx = b.st[1];
        if (nloc == 0u) { xcd_barrier_complete(bar, b.x, nloc, nx); b.st[0] = nloc; b.st[1] = nx; }
        const unsigned old = xb_add(&bar[XB_XSUB(b.x)], 1u);
        const unsigned gen = old / nloc;
        if (old + 1u == (gen + 1u) * nloc) {
            __builtin_amdgcn_fence(__ATOMIC_RELEASE, "agent");
            asm volatile("s_waitcnt vmcnt(0)" ::: "memory");
            const unsigned og = xb_add(&bar[XB_TOP], 1u);
            const unsigned tg = og / nx;
            if (og + 1u == (tg + 1u) * nx) xb_add(&bar[XB_TOPGEN], 1u);
            else XB_SPIN(xb_ld(&bar[XB_TOPGEN]) == tg, bar);
            __builtin_amdgcn_fence(__ATOMIC_ACQUIRE, "agent");
            xb_add(&bar[XB_XGEN(b.x)], 1u);
            asm volatile("s_waitcnt vmcnt(0)" ::: "memory");
        } else {
            XB_SPIN(xb_ld(&bar[XB_XGEN(b.x)]) == gen, bar);
            __builtin_amdgcn_fence(__ATOMIC_ACQUIRE, "agent");
            asm volatile("s_waitcnt vmcnt(0)" ::: "memory");
        }
    }
    __syncthreads();
}
namespace mk {
using pg8::bf16_t; using pg8::f32x4; using pg8::u32x4; using pg8::Unit;
#define LAS __attribute__((address_space(3)))
typedef unsigned u32x2 __attribute__((ext_vector_type(2)));
constexpr int MT = 40960, NCTX = 8192;
constexpr int NR = 1024, NS = 1536, NM = 1024;
constexpr int NSM = NS + NM;
constexpr size_t SZ_WR = 2ull * NR * 1024 * 2, SZ_WS = 2ull * NSM * 1024 * 2, SZ_WM = 0, SZ_WO = 2ull * 1024 * 1024 * 2, SZ_W13 = 2ull * 5632 * 1024 * 2, SZ_W2 = 2ull * 1024 * 2816 * 2;
constexpr size_t OFF_WR = 0, OFF_WS = OFF_WR + SZ_WR, OFF_WM = OFF_WS + SZ_WS, OFF_WO = OFF_WM + SZ_WM, OFF_W13 = OFF_WO + SZ_WO, OFF_W2 = OFF_W13 + SZ_W13, OFF_MOD = OFF_W2 + SZ_W2;
constexpr size_t SZ_MOD = 2ull * 9 * 6144 * 4;
constexpr size_t COLB = (size_t)MT * 2;
constexpr size_t OFF_LW = OFF_MOD + SZ_MOD, SZ_LW = 2ull * (4 * 256 * 32 + 256 * 64) * 2;
constexpr size_t OFF_H = OFF_LW + SZ_LW, OFF_OR = OFF_H + 1024 * COLB, OFF_GR = OFF_OR + 512 * COLB, OFF_BIG = OFF_GR + 256 * COLB;
constexpr size_t OFF_UR = OFF_BIG, OFF_PR = OFF_BIG + 1024 * COLB;
constexpr size_t OFF_ZS = OFF_BIG, OFF_PS = OFF_BIG + 512 * COLB, OFF_DT = OFF_BIG + 1280 * COLB, OFF_PM = OFF_BIG + 1344 * COLB, OFF_GM = OFF_BIG + 2112 * COLB, OFF_OG = OFF_BIG + 2144 * COLB;
constexpr size_t OFF_SH = OFF_BIG + 2400 * COLB;
constexpr size_t OFF_UD = OFF_SH + 768 * COLB;
constexpr size_t OFF_US = OFF_SH, OFF_UM = OFF_SH + 1024 * COLB, OFF_OS = OFF_SH, OFF_OM = OFF_SH + 1024 * COLB;
constexpr size_t OFF_ACT = OFF_BIG;
constexpr size_t WS_END = OFF_BIG + 3936 * COLB;
constexpr size_t OS_SSD = 41943040ull, OS_RWKV = OS_SSD + 4194304ull, OS_MC = OS_RWKV + 2097152ull, OS_MN = OS_MC + 2097152ull, OS_MM = OS_MN + 32768ull;
constexpr size_t OFF_BAR = WS_END, WS_END2 = OFF_BAR + 16384;
constexpr int LDS_BYTES = 131072 + 16;

struct Params { const float* in[40]; float* out; unsigned char* ws; int ph_lo, ph_hi; };

__device__ __forceinline__ int otid() { int t = threadIdx.x; asm volatile("" : "+v"(t)); return t; }
__device__ __forceinline__ float bf2f(unsigned v) { return __uint_as_float(v << 16); }
__device__ __forceinline__ float bflo(unsigned w) { return __uint_as_float(w << 16); }
__device__ __forceinline__ float bfhi(unsigned w) { return __uint_as_float(w & 0xffff0000u); }
typedef __bf16 bf16x2_t __attribute__((ext_vector_type(2)));
typedef float f32x2_t __attribute__((ext_vector_type(2)));
__device__ __forceinline__ unsigned pk2(float lo, float hi) { const f32x2_t v = {lo, hi}; const bf16x2_t b = __builtin_convertvector(v, bf16x2_t); return __builtin_bit_cast(unsigned, b); }
__device__ __forceinline__ bf16_t f2bf(float f) { const __bf16 b = (__bf16)f; return __builtin_bit_cast(unsigned short, b); }
__device__ __forceinline__ float rcpf_(float x) { return __builtin_amdgcn_rcpf(x); }
__device__ __forceinline__ float sigmoidf_(float x) { return rcpf_(1.f + __expf(-x)); }
__device__ __forceinline__ float siluf_(float x) { return x * rcpf_(1.f + __expf(-x)); }
__device__ __forceinline__ float softplusf_(float x) { return fmaxf(x, 0.f) + log1pf(__expf(-fabsf(x))); }
__device__ __forceinline__ float softplus_fast(float x) { return fmaxf(x, 0.f) + __logf(1.f + __expf(-fabsf(x))); }
__device__ __forceinline__ float tanhf_(float x) { return 1.f - 2.f * rcpf_(__expf(2.f * x) + 1.f); }
template <int CTRL> __device__ __forceinline__ float dppmov(float x) { return __int_as_float(__builtin_amdgcn_update_dpp(0, __float_as_int(x), CTRL, 0xF, 0xF, true)); }
template <int LPR> __device__ __forceinline__ float row_allreduce(float x) {
    x += dppmov<0xB1>(x); x += dppmov<0x4E>(x); x += dppmov<0x141>(x);
    if (LPR == 16) x += dppmov<0x140>(x);
    return x;
}
__device__ __forceinline__ float wave_sum(float x) {
    x = row_allreduce<16>(x);
    const int xi = __float_as_int(x);
    return __int_as_float(__builtin_amdgcn_readlane(xi, 0)) + __int_as_float(__builtin_amdgcn_readlane(xi, 16)) + __int_as_float(__builtin_amdgcn_readlane(xi, 32)) + __int_as_float(__builtin_amdgcn_readlane(xi, 48));
}
__device__ __forceinline__ const float* xsrc_row(const Params& p, int l, int r) {
    if (l == 0) return r < NCTX ? p.in[0] + (size_t)r * 1024 : p.in[1] + (size_t)(r - NCTX) * 1024;
    return p.out + (size_t)r * 1024;
}
__device__ __forceinline__ int cond_of_row(int r) { return r < NCTX ? 0 : 1 + ((r - NCTX) >> 12); }

__device__ __forceinline__ void transpose_job(const float* src, int K, int Nsrc, int c0, int ncols, int Npad, bf16_t* dst, int mode, float* tile, int xlo = 0, int xcnt = 0, int xc0 = 0) {
    const int tid = otid(), lane = tid & 63, w = __builtin_amdgcn_readfirstlane(tid >> 6);
    const int nkt = K / 64, nnt = Npad / 64, nit = nkt * nnt;
    for (int it0 = blockIdx.x; it0 < nit; it0 += 2 * gridDim.x) {
        float v[2][8];
#pragma unroll
        for (int h = 0; h < 2; ++h) { const int it = it0 + h * gridDim.x; if (it < nit) {
            const int kt = it / nnt, nt = it % nnt, k0 = kt * 64, n = nt * 64 + lane;
            const int scol = (n >= xlo && n < xlo + xcnt) ? xc0 + (n - xlo) : (n < ncols ? c0 + n : -1);
#pragma unroll
            for (int i = 0; i < 8; ++i) v[h][i] = scol >= 0 ? __builtin_nontemporal_load(src + (size_t)(k0 + w + 8 * i) * Nsrc + scol) : 0.f; } }
#pragma unroll
        for (int h = 0; h < 2; ++h) { if (it0 + h * gridDim.x < nit) {
#pragma unroll
            for (int i = 0; i < 8; ++i) tile[h * 64 * 65 + (w + 8 * i) * 65 + lane] = v[h][i]; } }
        __syncthreads();
#pragma unroll
        for (int h = 0; h < 2; ++h) { const int it = it0 + h * gridDim.x; if (it < nit) {
            const int kt = it / nnt, nt = it % nnt, k0 = kt * 64, n0 = nt * 64;
            const int nn = tid >> 3, kc = (tid & 7) * 8, ng = n0 + nn;
            const int drow = mode == 0 ? ng : ((ng >> 7) * 256 + (ng & 127) + (mode == 2 ? 128 : 0));
            const float* t = tile + h * 64 * 65;
            u32x4 o;
            o.x = pk2(t[(kc + 0) * 65 + nn], t[(kc + 1) * 65 + nn]); o.y = pk2(t[(kc + 2) * 65 + nn], t[(kc + 3) * 65 + nn]);
            o.z = pk2(t[(kc + 4) * 65 + nn], t[(kc + 5) * 65 + nn]); o.w = pk2(t[(kc + 6) * 65 + nn], t[(kc + 7) * 65 + nn]);
            *(u32x4*)(dst + (size_t)drow * K + k0 + kc) = o; } }
        __syncthreads();
    }
}
__device__ __forceinline__ void prologue_phase(const Params& p, float* sm) {
    for (int l = 0; l < 2; ++l) {
        const float* win = p.in[13] + (size_t)l * 1024 * 3296;
        transpose_job(win, 1024, 3296, 1296, 960, NR, (bf16_t*)(p.ws + OFF_WR) + (size_t)l * NR * 1024, 0, sm);
        transpose_job(win, 1024, 3296, 0, 1296, NS, (bf16_t*)(p.ws + OFF_WS) + (size_t)l * NSM * 1024, 0, sm, 1296, 16, 3280);
        transpose_job(win, 1024, 3296, 2256, 1024, NM, (bf16_t*)(p.ws + OFF_WS) + ((size_t)l * NSM + NS) * 1024, 0, sm);
        transpose_job(p.in[35] + (size_t)l * 1024 * 1024, 1024, 1024, 0, 1024, 1024, (bf16_t*)(p.ws + OFF_WO) + (size_t)l * 1024 * 1024, 0, sm);
        transpose_job(p.in[36] + (size_t)l * 1024 * 2816, 1024, 2816, 0, 2816, 2816, (bf16_t*)(p.ws + OFF_W13) + (size_t)l * 5632 * 1024, 1, sm);
        transpose_job(p.in[37] + (size_t)l * 1024 * 2816, 1024, 2816, 0, 2816, 2816, (bf16_t*)(p.ws + OFF_W13) + (size_t)l * 5632 * 1024, 2, sm);
        transpose_job(p.in[38] + (size_t)l * 2816 * 1024, 2816, 1024, 0, 1024, 1024, (bf16_t*)(p.ws + OFF_W2) + (size_t)l * 1024 * 2816, 0, sm);
    }
    {
        bf16_t* LW = (bf16_t*)(p.ws + OFF_LW);
        for (int i = blockIdx.x * 512 + otid(); i < 2 * 49152; i += gridDim.x * 512) {
            const int l = i / 49152, j = i % 49152;
            float v;
            if (j < 32768) { const int mat = j >> 13, c = (j >> 5) & 255, k = j & 31; v = (mat < 2 ? p.in[22] : p.in[24])[((size_t)(l * 2 + (mat & 1)) * 32 + k) * 256 + c]; }
            else { const int jj = j - 32768, c = jj >> 6, k = jj & 63; v = p.in[25][((size_t)l * 64 + k) * 256 + c]; }
            LW[i] = f2bf(v);
        }
    }
    const int tid = otid(), lane = tid & 63, kg = __builtin_amdgcn_readfirstlane(tid >> 6);
    float* red = sm + 9 * 1024;
    for (int i = tid; i < 9 * 1024; i += 512) { const int ci = i >> 10, k = i & 1023; const float v = ci == 0 ? p.in[8][k] : p.in[7][(ci - 1) * 1024 + k]; sm[i] = siluf_(v); }
    __syncthreads();
    float* mod = (float*)(p.ws + OFF_MOD);
    for (int it = blockIdx.x; it < 192; it += gridDim.x) {
        const int l = it / 96, nb = (it % 96) * 64;
        const float* W = p.in[9] + (size_t)l * 1024 * 6144 + nb + lane;
        float acc[9];
#pragma unroll
        for (int ci = 0; ci < 9; ++ci) acc[ci] = 0.f;
#pragma unroll 8
        for (int k = kg * 128; k < kg * 128 + 128; ++k) {
            const float w = __builtin_nontemporal_load(W + (size_t)k * 6144);
#pragma unroll
            for (int ci = 0; ci < 9; ++ci) acc[ci] += sm[ci * 1024 + k] * w;
        }
#pragma unroll
        for (int ci = 0; ci < 9; ++ci) red[(kg * 9 + ci) * 64 + lane] = acc[ci];
        __syncthreads();
        for (int i = tid; i < 576; i += 512) {
            const int ci = i >> 6, ln = i & 63; float s = 0.f;
            for (int g = 0; g < 8; ++g) s += red[(g * 9 + ci) * 64 + ln];
            mod[(size_t)(l * 9 + ci) * 6144 + nb + ln] = s + p.in[10][l * 6144 + nb + ln];
        }
        __syncthreads();
    }
}

__device__ __forceinline__ void norm_phase(const Params& p, int l, int which, int rlo = 0, int rhi = MT, const bf16_t* xsrc = nullptr, bf16_t* tmp = nullptr) {
    constexpr int NRW = 2;
    const int lane = otid() & 63, gw = blockIdx.x * 8 + __builtin_amdgcn_readfirstlane(otid() >> 6), nw = gridDim.x * 8;
    const float* g = which >= 2 ? p.in[39] : p.in[which ? 12 : 11] + l * 1024;
    const float* mod = (const float*)(p.ws + OFF_MOD) + (size_t)l * 9 * 6144;
    bf16_t* H = (bf16_t*)(p.ws + OFF_H);
    const bf16_t* XB = xsrc ? xsrc : (const bf16_t*)p.out;
    const bool f32src = which == 0 && l == 0;
    const int sh_off = which ? 3072 : 0, sc_off = which ? 4096 : 1024;
    auto load_rows = [&](int r0, f32x4 (&v)[NRW][4]) {
#pragma unroll
        for (int q = 0; q < NRW; ++q) { const int r = r0 + q * nw < rhi ? r0 + q * nw : r0;
            if (f32src) { const float* x = xsrc_row(p, 0, r);
#pragma unroll
                for (int j = 0; j < 4; ++j) v[q][j] = ((const f32x4*)x)[lane + 64 * j]; }
            else { const bf16_t* x = XB + (size_t)r * 1024;
#pragma unroll
                for (int j = 0; j < 2; ++j) { const u32x4 w = *(const u32x4*)(x + (lane + 64 * j) * 8);
                    v[q][2 * j] = (f32x4){bflo(w.x), bfhi(w.x), bflo(w.y), bfhi(w.y)}; v[q][2 * j + 1] = (f32x4){bflo(w.z), bfhi(w.z), bflo(w.w), bfhi(w.w)}; } } }
    };
    f32x4 ggv[4];
#pragma unroll
    for (int j = 0; j < 4; ++j) ggv[j] = *(const f32x4*)(g + (f32src ? (lane + 64 * j) * 4 : (lane + 64 * (j >> 1)) * 8 + (j & 1) * 4));
    f32x4 vn[NRW][4];
    if (rlo + gw < rhi) load_rows(rlo + gw, vn);
    for (int r0 = rlo + gw; r0 < rhi; r0 += NRW * nw) {
        f32x4 v[NRW][4]; float ss[NRW];
#pragma unroll
        for (int q = 0; q < NRW; ++q)
#pragma unroll
            for (int j = 0; j < 4; ++j) v[q][j] = vn[q][j];
        if (r0 + NRW * nw < rhi) load_rows(r0 + NRW * nw, vn);
        if (which == 3) {
#pragma unroll
            for (int q = 0; q < NRW; ++q) { const int r = r0 + q * nw; if (r >= rhi) break;
#pragma unroll
                for (int j = 0; j < 2; ++j) { u32x4 w; w.x = pk2(v[q][2 * j].x, v[q][2 * j].y); w.y = pk2(v[q][2 * j].z, v[q][2 * j].w); w.z = pk2(v[q][2 * j + 1].x, v[q][2 * j + 1].y); w.w = pk2(v[q][2 * j + 1].z, v[q][2 * j + 1].w);
                    *(u32x4*)(tmp + (size_t)r * 1024 + (lane + 64 * j) * 8) = w; } }
            continue;
        }
#pragma unroll
        for (int q = 0; q < NRW; ++q) { float s = 0.f;
#pragma unroll
            for (int j = 0; j < 4; ++j) s += v[q][j].x * v[q][j].x + v[q][j].y * v[q][j].y + v[q][j].z * v[q][j].z + v[q][j].w * v[q][j].w;
            ss[q] = wave_sum(s); }
#pragma unroll
        for (int q = 0; q < NRW; ++q) { const int r = r0 + q * nw; if (r >= rhi) break;
            const float rstd = rsqrtf(ss[q] * (1.f / 1024.f) + 1e-6f);
            const float* mc = mod + cond_of_row(r) * 6144;
#pragma unroll
            for (int j = 0; j < 4; ++j) {
                const int col = f32src ? (lane + 64 * j) * 4 : (lane + 64 * (j >> 1)) * 8 + (j & 1) * 4;
                const f32x4 gg = ggv[j];
                if (which == 2) { *(f32x4*)(p.out + (size_t)r * 1024 + col) = v[q][j] * rstd * gg; }
                else { const f32x4 sc = *(const f32x4*)(mc + sc_off + col), sh = *(const f32x4*)(mc + sh_off + col);
                    const f32x4 o = v[q][j] * rstd * gg * (sc + 1.f) + sh;
                    u32x2 w; w.x = pk2(o.x, o.y); w.y = pk2(o.z, o.w);
                    *(u32x2*)(H + (size_t)r * 1024 + col) = w; }
            } }
    }
}

struct EpiStoreBf16 {
    static constexpr bool PERM = true, AFTER_DRAIN = false;
    bf16_t* O; int ldc;
    __device__ __forceinline__ void operator()(const f32x4 (&acc)[2][2][4][2], const Unit& u, int wr, int wc, int fr, int fq) const {
        const int row0 = u.pm * 256 + wr * 64 + fr, col0 = u.pn * 256 + wc * 32 + 8 * fq;
#pragma unroll
        for (int ai = 0; ai < 2; ++ai)
#pragma unroll
            for (int m = 0; m < 4; ++m) { bf16_t* rowp = O + (size_t)(row0 + ai * 128 + m * 16) * ldc + col0;
#pragma unroll
                for (int bj = 0; bj < 2; ++bj) { const f32x4 v0 = acc[ai][bj][m][0], v1 = acc[ai][bj][m][1];
                    u32x4 w; w.x = pk2(v0[0], v0[1]); w.y = pk2(v0[2], v0[3]); w.z = pk2(v1[0], v1[1]); w.w = pk2(v1[2], v1[3]);
                    *(u32x4*)(rowp + bj * 128) = w; } }
    }
};
template <int ACT> __device__ __forceinline__ void store_tile_bf16(const f32x4 (&acc)[2][2][4][2], bf16_t* O, int ldc, int cb, int row0) {
#pragma unroll
    for (int ai = 0; ai < 2; ++ai)
#pragma unroll
        for (int m = 0; m < 4; ++m) { bf16_t* rowp = O + (size_t)(row0 + ai * 128 + m * 16) * ldc + cb;
#pragma unroll
            for (int bj = 0; bj < 2; ++bj) { f32x4 v0 = acc[ai][bj][m][0], v1 = acc[ai][bj][m][1];
                if (ACT) {
#pragma unroll
                    for (int j = 0; j < 4; ++j) { const float s0 = rcpf_(1.f + __expf(-v0[j])), s1 = rcpf_(1.f + __expf(-v1[j])); v0[j] = ACT == 1 ? v0[j] * s0 : s0; v1[j] = ACT == 1 ? v1[j] * s1 : s1; } }
                u32x4 w; w.x = pk2(v0[0], v0[1]); w.y = pk2(v0[2], v0[3]); w.z = pk2(v1[0], v1[1]); w.w = pk2(v1[2], v1[3]);
                *(u32x4*)(rowp + bj * 128) = w; }
            asm volatile("" ::: "memory"); }
}
struct EpiSSD {
    static constexpr bool PERM = true, AFTER_DRAIN = false;
    bf16_t* Zs; bf16_t* UC; bf16_t* UD;
    __device__ __forceinline__ void operator()(const f32x4 (&acc)[2][2][4][2], const Unit& u, int wr, int wc, int fr, int fq) const {
        const int row0 = u.pm * 256 + wr * 64 + fr, cin = wc * 32 + 8 * fq;
        if (u.pn < 2) store_tile_bf16<1>(acc, Zs, 512, u.pn * 256 + cin, row0);
        else if (u.pn < 5) store_tile_bf16<0>(acc, UC, 768, (u.pn - 2) * 256 + cin, row0);
        else store_tile_bf16<0>(acc, UD, 256, cin, row0);
    }
};
struct EpiMLSTM {
    static constexpr bool PERM = true, AFTER_DRAIN = false;
    bf16_t* UC; bf16_t* PM; bf16_t* OG;
    __device__ __forceinline__ void operator()(const f32x4 (&acc)[2][2][4][2], const Unit& u, int wr, int wc, int fr, int fq) const {
        const int row0 = u.pm * 256 + wr * 64 + fr, cin = wc * 32 + 8 * fq;
        if (u.pn < 2) store_tile_bf16<0>(acc, UC, 512, u.pn * 256 + cin, row0);
        else if (u.pn == 2) store_tile_bf16<0>(acc, PM + 512, 768, cin, row0);
        else store_tile_bf16<2>(acc, OG, 256, cin, row0);
    }
};
struct EpiSM {
    static constexpr bool PERM = true, AFTER_DRAIN = false;
    EpiSSD es; EpiMLSTM em;
    __device__ __forceinline__ void operator()(const f32x4 (&acc)[2][2][4][2], const Unit& u, int wr, int wc, int fr, int fq) const {
        if (u.pn < 6) es(acc, u, wr, wc, fr, fq);
        else { Unit v; v.pm = u.pm; v.pn = u.pn - 6; em(acc, v, wr, wc, fr, fq); }
    }
};
struct EpiSwiglu {
    static constexpr bool PERM = true, AFTER_DRAIN = false;
    bf16_t* O;
    __device__ __forceinline__ void operator()(const f32x4 (&acc)[2][2][4][2], const Unit& u, int wr, int wc, int fr, int fq) const {
        const int row0 = u.pm * 256 + wr * 64 + fr, col0 = u.pn * 128 + wc * 32 + 8 * fq;
#pragma unroll
        for (int ai = 0; ai < 2; ++ai)
#pragma unroll
            for (int m = 0; m < 4; ++m) { bf16_t* rowp = O + (size_t)(row0 + ai * 128 + m * 16) * 2816 + col0;
                f32x4 a[2];
#pragma unroll
                for (int n = 0; n < 2; ++n) { const f32x4 g = acc[ai][0][m][n], up = acc[ai][1][m][n];
#pragma unroll
                    for (int j = 0; j < 4; ++j) a[n][j] = g[j] * rcpf_(1.f + __expf(-g[j])) * up[j]; }
                u32x4 w; w.x = pk2(a[0][0], a[0][1]); w.y = pk2(a[0][2], a[0][3]); w.z = pk2(a[1][0], a[1][1]); w.w = pk2(a[1][2], a[1][3]);
                *(u32x4*)rowp = w;
                asm volatile("" ::: "memory"); }
    }
};
struct EpiResidual {
    static constexpr bool PERM = true, AFTER_DRAIN = false;
    const float* xp; const float* xs; int from_inputs; bf16_t* xb; const float* gate; bf16_t* xo;
    __device__ __forceinline__ void operator()(const f32x4 (&acc)[2][2][4][2], const Unit& u, int wr, int wc, int fr, int fq) const {
        const int rb = u.pm * 256, row0 = rb + wr * 64 + fr, col0 = u.pn * 256 + wc * 32 + 8 * fq;
        const float* gp = gate + cond_of_row(rb) * 6144 + col0;
        f32x4 gq[2][2];
#pragma unroll
        for (int bj = 0; bj < 2; ++bj) { gq[bj][0] = *(const f32x4*)(gp + bj * 128); gq[bj][1] = *(const f32x4*)(gp + bj * 128 + 4); }
#pragma unroll
        for (int ai = 0; ai < 2; ++ai)
#pragma unroll
            for (int m = 0; m < 4; ++m) { const int r = row0 + ai * 128 + m * 16;
                bf16_t* op = xb + (size_t)r * 1024 + col0; bf16_t* wp = xo + (size_t)r * 1024 + col0;
#pragma unroll
                for (int bj = 0; bj < 2; ++bj) { f32x4 r0v, r1v;
                    if (from_inputs) { const float* res = (r < NCTX ? xp + (size_t)r * 1024 : xs + (size_t)(r - NCTX) * 1024) + col0 + bj * 128; r0v = *(const f32x4*)res; r1v = *(const f32x4*)(res + 4); }
                    else { const u32x4 w = *(const u32x4*)(op + bj * 128); r0v = (f32x4){bflo(w.x), bfhi(w.x), bflo(w.y), bfhi(w.y)}; r1v = (f32x4){bflo(w.z), bfhi(w.z), bflo(w.w), bfhi(w.w)}; }
                    const f32x4 g0 = gq[bj][0], g1 = gq[bj][1];
                    const f32x4 o0 = r0v + g0 * acc[ai][bj][m][0], o1 = r1v + g1 * acc[ai][bj][m][1];
                    u32x4 w; w.x = pk2(o0.x, o0.y); w.y = pk2(o0.z, o0.w); w.z = pk2(o1.x, o1.y); w.w = pk2(o1.z, o1.w);
                    *(u32x4*)(wp + bj * 128) = w; }
                asm volatile("" ::: "memory"); }
    }
};
template <class Epi> __device__ __forceinline__ void run_gemm(LAS unsigned char* lds, const bf16_t* A, const bf16_t* Bt, int N, int K, const Epi& E) {
    pg8::Gemm g{A, Bt, MT, N, K}; pg8::StaticOrder S; S.init(MT, N, (int)gridDim.x, (int)blockIdx.x);
    pg8::gemm_phase<Epi, pg8::StaticOrder, false>(lds, g, S, E, nullptr);
}
__device__ __forceinline__ void prep_rwkv(const Params& p, int l, float* sm) {
    const int tid = otid(), lane = tid & 63, wid = __builtin_amdgcn_readfirstlane(tid >> 6);
    const bf16_t* U = (const bf16_t*)(p.ws + OFF_UR);
    bf16_t* P = (bf16_t*)(p.ws + OFF_PR);
    bf16_t* G = (bf16_t*)(p.ws + OFF_GR);
    const float* mu = p.in[20] + l * 960;
    float* um = sm; float* rs = sm + 16 * 960;
    bf16_t* actb = (bf16_t*)(sm + 16 * 960 + 64);
    const bf16_t* LW = (const bf16_t*)(p.ws + OFF_LW) + (size_t)l * 49152;
    const int fr = lane & 15, fq = lane >> 4;
    const int c = tid & 255, half = tid >> 8;
    const float kkc = p.in[26][l * 256 + c];
    pg8::bf16x8 bw[10][2];
#pragma unroll
    for (int jj = 0; jj < 10; ++jj) { const int job = wid * 10 + jj, mat = job >> 4, nt = job & 15;
        if (mat < 4) { bw[jj][0] = *(const pg8::bf16x8*)(LW + ((size_t)(mat * 256 + nt * 16 + fr)) * 32 + fq * 8); bw[jj][1] = bw[jj][0]; }
        else { const bf16_t* g = LW + 32768 + (size_t)(nt * 16 + fr) * 64 + fq * 8; bw[jj][0] = *(const pg8::bf16x8*)g; bw[jj][1] = *(const pg8::bf16x8*)(g + 32); } }
    float biasr[10];
#pragma unroll
    for (int jj = 0; jj < 10; ++jj) { const int job = wid * 10 + jj, mat = job >> 4, cc = (job & 15) * 16 + fr, d = mat & 1;
        biasr[jj] = mat < 2 ? p.in[21][(l * 2 + d) * 256 + cc] : mat < 4 ? p.in[23][(l * 2 + d) * 256 + cc] : 0.f; }
    const int chm = tid & 127, c0m = (chm < 120 ? chm : 119) * 8;
    const f32x4 mu0 = *(const f32x4*)(mu + c0m), mu1 = *(const f32x4*)(mu + c0m + 4);
    f32x4 kkm0 = {0.f, 0.f, 0.f, 0.f}, kkm1 = {0.f, 0.f, 0.f, 0.f};
    if (c0m >= 256 && c0m < 512) { kkm0 = *(const f32x4*)(p.in[26] + l * 256 + (c0m - 256)); kkm1 = *(const f32x4*)(p.in[26] + l * 256 + (c0m - 256) + 4); }
    const f32x4 kks0 = *(const f32x4*)(p.in[26] + l * 256 + (tid & 31) * 8), kks1 = *(const f32x4*)(p.in[26] + l * 256 + (tid & 31) * 8 + 4);
    for (int tile = blockIdx.x; tile < MT / 16; tile += gridDim.x) {
        const int r0 = tile * 16;
        {
            const bool ctx = r0 < NCTX;
#pragma unroll 1
            for (int bt = 0; bt < 2; ++bt) {
                u32x4 own[2], nb[2][4];
#pragma unroll
                for (int k = 0; k < 2; ++k) {
                    const int item = (bt * 2 + k) * 512 + tid, tk = item >> 7, ch = item & 127, chc = ch < 120 ? ch : 119, r = r0 + tk;
                    const bf16_t* ur = U + (size_t)r * 1024 + chc * 8;
                    own[k] = *(const u32x4*)ur;
                    if (ctx) { const int t = r & 255; nb[k][0] = *(const u32x4*)(ur + (t > 0 ? -1024 : 0)); nb[k][1] = *(const u32x4*)(ur + (t < 255 ? 1024 : 0)); nb[k][2] = nb[k][0]; nb[k][3] = nb[k][1]; }
                    else { const int t = (r - NCTX) & 4095, gx = t & 63, gy = t >> 6;
                        nb[k][0] = *(const u32x4*)(ur + (gx > 0 ? -1024 : 0)); nb[k][1] = *(const u32x4*)(ur + (gx < 63 ? 1024 : 0));
                        nb[k][2] = *(const u32x4*)(ur + (gy > 0 ? -65536 : 0)); nb[k][3] = *(const u32x4*)(ur + (gy < 63 ? 65536 : 0)); }
                }
#pragma unroll
                for (int k = 0; k < 2; ++k) {
                    const int item = (bt * 2 + k) * 512 + tid, tk = item >> 7, ch = item & 127, r = r0 + tk;
                    float ssq = 0.f;
                    if (ch < 120) {
                        const int c0 = ch * 8;
                        bool v0, v1, v2, v3;
                        if (ctx) { const int t = r & 255; v0 = t > 0; v1 = t < 255; v2 = v0; v3 = v1; }
                        else { const int t = (r - NCTX) & 4095, gx = t & 63, gy = t >> 6; v0 = gx > 0; v1 = gx < 63; v2 = gy > 0; v3 = gy < 63; }
                        float m[8];
#pragma unroll
                        for (int j = 0; j < 4; ++j) {
                            const int n0 = (j & 1) ? 2 : 0, n1 = (j & 1) ? 3 : 1;
                            const float u0 = bflo(own[k][j]), u1 = bfhi(own[k][j]);
                            const float s0 = ((j & 1) ? v2 : v0) ? bflo(nb[k][n0][j]) : 0.f, s1 = ((j & 1) ? v3 : v1) ? bfhi(nb[k][n1][j]) : 0.f;
                            const float mua = j < 2 ? mu0[2 * j] : mu1[2 * j - 4], mub = j < 2 ? mu0[2 * j + 1] : mu1[2 * j - 3];
                            m[2 * j] = u0 + (s0 - u0) * mua; m[2 * j + 1] = u1 + (s1 - u1) * mub;
                        }
                        if (c0 >= 768 && c0 < 832) {
#pragma unroll
                            for (int j = 0; j < 8; ++j) m[j] = tanhf_(m[j]); }
                        else if (c0 >= 896) {
#pragma unroll
                            for (int j = 0; j < 8; ++j) m[j] = sigmoidf_(m[j]); }
                        *(f32x4*)(um + tk * 960 + c0) = (f32x4){m[0], m[1], m[2], m[3]}; *(f32x4*)(um + tk * 960 + c0 + 4) = (f32x4){m[4], m[5], m[6], m[7]};
                        if (c0 >= 256 && c0 < 512) {
#pragma unroll
                            for (int j = 0; j < 8; ++j) { const float t = m[j] * (j < 4 ? kkm0[j] : kkm1[j - 4]); ssq += t * t; } }
                        if (c0 >= 768) { u32x4 w; w.x = pk2(m[0], m[1]); w.y = pk2(m[2], m[3]); w.z = pk2(m[4], m[5]); w.w = pk2(m[6], m[7]); *(u32x4*)(actb + tk * 200 + (c0 - 768)) = w; }
                    }
                    ssq = row_allreduce<8>(ssq);
                    if (ch >= 32 && ch < 64 && (ch & 7) == 0) rs[tk * 4 + ((ch - 32) >> 3)] = rsqrtf(ssq + 1e-12f);
                }
            }
        }
        __syncthreads();
#pragma unroll
        for (int it = 0; it < 4; ++it) {
            const int item = it * 512 + tid;
            int tk, c0; bool iskk = item >= 1536;
            if (!iskk) { tk = item / 96; c0 = (item % 96) * 8; } else { tk = (item - 1536) >> 5; c0 = 256 + ((item - 1536) & 31) * 8; }
            f32x4 a = *(const f32x4*)(um + tk * 960 + c0), b2 = *(const f32x4*)(um + tk * 960 + c0 + 4);
            if (iskk) { const float sc = rs[tk * 4 + ((c0 - 256) >> 6)]; a = a * kks0 * sc; b2 = b2 * kks1 * sc; }
            u32x4 w; w.x = pk2(a.x, a.y); w.y = pk2(a.z, a.w); w.z = pk2(b2.x, b2.y); w.w = pk2(b2.z, b2.w);
            *(u32x4*)(P + (size_t)(r0 + tk) * 2048 + (iskk ? 768 + (c0 - 256) : c0)) = w;
        }
        {
            bf16_t* prow = P + (size_t)(r0 + fq * 4) * 2048; bf16_t* grow = G + (size_t)(r0 + fq * 4) * 256;
#pragma unroll
            for (int jj = 0; jj < 10; ++jj) { const int job = wid * 10 + jj, mat = job >> 4, nt = job & 15, cc = nt * 16 + fr;
                f32x4 acc = {0.f, 0.f, 0.f, 0.f};
                const pg8::bf16x8 a0 = *(const pg8::bf16x8*)(actb + fr * 200 + (mat < 4 ? mat * 32 : 128) + fq * 8);
                acc = __builtin_amdgcn_mfma_f32_16x16x32_bf16(a0, bw[jj][0], acc, 0, 0, 0);
                if (mat == 4) { const pg8::bf16x8 a1 = *(const pg8::bf16x8*)(actb + fr * 200 + 160 + fq * 8); acc = __builtin_amdgcn_mfma_f32_16x16x32_bf16(a1, bw[jj][1], acc, 0, 0, 0); }
                const int d = mat & 1;
                const float bias = biasr[jj];
#pragma unroll
                for (int i = 0; i < 4; ++i) { const float z = acc[i] + bias;
                    if (mat < 2) { const float x = 0.60653066f * sigmoidf_(z); prow[i * 2048 + 1536 + d * 256 + cc] = f2bf(1.f - __expf(-x)); }
                    else if (mat < 4) prow[i * 2048 + 1024 + d * 256 + cc] = f2bf(sigmoidf_(z));
                    else grow[i * 256 + cc] = f2bf(z); }
            }
        }
        __syncthreads();
    }
}

template <int LPR> __device__ __forceinline__ void scan_rwkv(const Params& p, int l, LAS float* lds) {
    constexpr int REC = 388, SLAB = 32, EPL = 64 / LPR, RPW = 64 / LPR, RPB = 4 * RPW, UPI = 64 / RPB, NV = EPL / 4;
    const int tid = otid(), wid = __builtin_amdgcn_readfirstlane(tid >> 6), lane = tid & 63, lr = lane & (LPR - 1);
    const bf16_t* P = (const bf16_t*)(p.ws + OFF_PR);
    bf16_t* O = (bf16_t*)(p.ws + OFF_OR);
    const bool lat = LPR == 16;
    const int nunits = (lat ? 64 : 256) * UPI;
    for (int uu = blockIdx.x; uu < nunits; uu += gridDim.x) {
        const int q = (uu >> 3) & (UPI - 1), item = (uu & 7) | ((uu / (8 * UPI)) << 3);
        const int d = item & 1, h = (item >> 1) & 3, b = item >> 3;
        const int base = lat ? NCTX + b * 4096 : b * 256, T = lat ? 4096 : 256, nslab = T / SLAB;
        const int irow = q * RPB + (wid & 3) * RPW + lane / LPR;
        f32x4 s[NV];
#pragma unroll
        for (int v = 0; v < NV; ++v) s[v] = (f32x4){0.f, 0.f, 0.f, 0.f};
        if (wid < 4 && lat) {
#pragma unroll
            for (int v = 0; v < NV; ++v) s[v] = *(const f32x4*)(p.in[3] + ((size_t)(((b * 2 + l) * 2 + d) * 4 + h) * 64 + irow) * 64 + lr * EPL + 4 * v); }
        const float ka = p.in[27][l * 256 + h * 64 + lane], rk1 = 1.f + p.in[28][l * 256 + h * 64 + lane];
        unsigned ra[8][6];
        auto issue = [&](int sl, unsigned (&raw)[8][6]) {
            const int pw = wid - 4;
            const int step0 = sl * SLAB + pw * 8, t0 = d ? T - 1 - step0 : step0, dstep = d ? -2048 : 2048;
            const bf16_t* pr0 = P + (size_t)(base + t0) * 2048 + h * 64 + lane;
#pragma unroll
            for (int j = 0; j < 8; ++j) {
                const bf16_t* pr = pr0 + j * dstep;
                raw[j][0] = pr[0]; raw[j][1] = pr[256]; raw[j][2] = pr[512]; raw[j][3] = pr[768]; raw[j][4] = pr[1024 + d * 256]; raw[j][5] = pr[1536 + d * 256];
            }
        };
        auto finish = [&](int sl, const unsigned (&raw)[8][6]) {
            const int pw = wid - 4;
#pragma unroll
            for (int j = 0; j < 8; ++j) {
                const int js = pw * 8 + j;
                const float r = bf2f(raw[j][0]), k = bf2f(raw[j][1]), v = bf2f(raw[j][2]), kk = bf2f(raw[j][3]), a = bf2f(raw[j][4]), omw = bf2f(raw[j][5]);
                const float w = 1.f - omw, bb = a * kk, kd = k * (1.f + (a - 1.f) * ka), wr = w * r;
                const float br = wave_sum(bb * r), c1 = wave_sum(kd * r * rk1);
                LAS float* rec = lds + ((sl & 1) * SLAB + js) * REC;
                rec[lane] = w; rec[64 + lane] = bb; rec[128 + lane] = kd; rec[192 + lane] = kk; rec[256 + lane] = wr; rec[320 + lane] = v;
                if (lane == 0) { rec[384] = br; rec[385] = c1; }
            }
        };
        auto consume = [&](int sl) {
            const LAS float* rbp = lds + (sl & 1) * SLAB * REC;
            f32x4 w4n[NV], b4n[NV], kd4n[NV], kk4n[NV], wr4n[NV];
#pragma unroll
            for (int v = 0; v < NV; ++v) { const int o = lr * EPL + 4 * v;
                w4n[v] = *(const LAS f32x4*)(rbp + o); b4n[v] = *(const LAS f32x4*)(rbp + 64 + o); kd4n[v] = *(const LAS f32x4*)(rbp + 128 + o); kk4n[v] = *(const LAS f32x4*)(rbp + 192 + o); wr4n[v] = *(const LAS f32x4*)(rbp + 256 + o); }
            float vin = rbp[320 + irow], brn = rbp[384], c1n = rbp[385];
            float ybuf = 0.f;
#pragma unroll(LPR == 16 ? 8 : 4)
            for (int j = 0; j < SLAB; ++j) {
                f32x4 w4[NV], b4[NV], kd4[NV], kk4[NV], wr4[NV];
#pragma unroll
                for (int v = 0; v < NV; ++v) { w4[v] = w4n[v]; b4[v] = b4n[v]; kd4[v] = kd4n[v]; kk4[v] = kk4n[v]; wr4[v] = wr4n[v]; }
                const float vi = vin, br = brn, c1 = c1n;
                if (j + 1 < SLAB) { const LAS float* rec = rbp + (j + 1) * REC;
#pragma unroll
                    for (int v = 0; v < NV; ++v) { const int o = lr * EPL + 4 * v;
                        w4n[v] = *(const LAS f32x4*)(rec + o); b4n[v] = *(const LAS f32x4*)(rec + 64 + o); kd4n[v] = *(const LAS f32x4*)(rec + 128 + o); kk4n[v] = *(const LAS f32x4*)(rec + 192 + o); wr4n[v] = *(const LAS f32x4*)(rec + 256 + o); }
                    vin = rec[320 + irow]; brn = rec[384]; c1n = rec[385]; }
                float p1 = 0.f, p2 = 0.f;
#pragma unroll
                for (int v = 0; v < NV; ++v) { p1 += s[v].x * kk4[v].x + s[v].y * kk4[v].y + s[v].z * kk4[v].z + s[v].w * kk4[v].w; p2 += s[v].x * wr4[v].x + s[v].y * wr4[v].y + s[v].z * wr4[v].z + s[v].w * wr4[v].w; }
                p1 = row_allreduce<LPR>(p1); p2 = row_allreduce<LPR>(p2);
                const float y = p2 - p1 * br + vi * c1;
#pragma unroll
                for (int v = 0; v < NV; ++v) s[v] = s[v] * w4[v] - p1 * b4[v] + vi * kd4[v];
                ybuf = (lr == (j & (LPR - 1))) ? y : ybuf;
                if ((j & (LPR - 1)) == LPR - 1) { const int step = sl * SLAB + (j - (LPR - 1)) + lr, t = d ? T - 1 - step : step;
                    O[(size_t)(base + t) * 512 + d * 256 + h * 64 + irow] = f2bf(ybuf); }
            }
        };
        if (wid >= 4) { issue(0, ra); finish(0, ra); issue(1, ra); }
        __syncthreads();
        if (wid < 4) __builtin_amdgcn_s_setprio(3);
        for (int sl = 0; sl < nslab; ++sl) {
            if (wid >= 4) { if (sl + 1 < nslab) finish(sl + 1, ra); if (sl + 2 < nslab) issue(sl + 2, ra); } else consume(sl);
            __syncthreads();
        }
        if (wid < 4) __builtin_amdgcn_s_setprio(0);
        if (wid < 4 && !lat) {
#pragma unroll
            for (int v = 0; v < NV; ++v) *(f32x4*)(p.out + OS_RWKV + ((size_t)(((b * 2 + l) * 2 + d) * 4 + h) * 64 + irow) * 64 + lr * EPL + 4 * v) = s[v]; }
    }
}

__device__ __forceinline__ void conv8_silu(const u32x4 pv, const u32x4 cv, const u32x4 nv, const float (&w)[32], float scale, u32x4& out) {
    float o[8];
#pragma unroll
    for (int j = 0; j < 4; ++j) {
        o[2 * j] = siluf_(w[24 + 2 * j] + w[2 * j] * bflo(pv[j]) + w[8 + 2 * j] * bflo(cv[j]) + w[16 + 2 * j] * bflo(nv[j])) * scale;
        o[2 * j + 1] = siluf_(w[24 + 2 * j + 1] + w[2 * j + 1] * bfhi(pv[j]) + w[8 + 2 * j + 1] * bfhi(cv[j]) + w[16 + 2 * j + 1] * bfhi(nv[j])) * scale;
    }
    out.x = pk2(o[0], o[1]); out.y = pk2(o[2], o[3]); out.z = pk2(o[4], o[5]); out.w = pk2(o[6], o[7]);
}
__device__ __forceinline__ void prep_ssd(const Params& p, int l) {
    const int lane = otid() & 63, gw = blockIdx.x * 8 + __builtin_amdgcn_readfirstlane(otid() >> 6), nw = gridDim.x * 8;
    const bf16_t* U = (const bf16_t*)(p.ws + OFF_US);
    bf16_t* P = (bf16_t*)(p.ws + OFF_PS); float* DT = (float*)(p.ws + OFF_DT); const bf16_t* UD = (const bf16_t*)(p.ws + OFF_UD);
    const float* cw = p.in[14] + l * 3 * 768; const float* cb = p.in[15] + l * 768;
    float w[3][32]; int qk[3], ck[3];
#pragma unroll
    for (int k = 0; k < 3; ++k) { const int g = lane + 64 * k; qk[k] = g / 96; ck[k] = (g % 96) * 8;
#pragma unroll
        for (int j = 0; j < 8; ++j) { w[k][j] = cw[ck[k] + j]; w[k][8 + j] = cw[768 + ck[k] + j]; w[k][16 + j] = cw[1536 + ck[k] + j]; w[k][24 + j] = cb[ck[k] + j]; } }
    const float dtb = lane < 16 ? p.in[16][l * 16 + lane] : 0.f, na = lane < 16 ? -__expf(p.in[17][l * 16 + lane]) : 0.f;
    u32x4 cvn[3], pvn[3], nvn[3]; float rawn[2];
    auto load_rows = [&](int r0) {
#pragma unroll
        for (int k = 0; k < 3; ++k) { const int r = r0 + qk[k] * nw < MT ? r0 + qk[k] * nw : r0;
            int t, T; if (r < NCTX) { t = r & 255; T = 256; } else { t = (r - NCTX) & 4095; T = 4096; }
            const bf16_t* ur = U + (size_t)r * 768 + ck[k];
            cvn[k] = *(const u32x4*)ur; pvn[k] = *(const u32x4*)(ur - (t > 0 ? 768 : 0)); nvn[k] = *(const u32x4*)(ur + (t < T - 1 ? 768 : 0));
            if (t == 0) pvn[k] = (u32x4){0u, 0u, 0u, 0u}; if (t == T - 1) nvn[k] = (u32x4){0u, 0u, 0u, 0u}; }
#pragma unroll
        for (int q = 0; q < 2; ++q) { const int r = r0 + q * nw < MT ? r0 + q * nw : r0; rawn[q] = lane < 16 ? bf2f(UD[(size_t)r * 256 + lane]) : 0.f; }
    };
    if (gw < MT) load_rows(gw);
    for (int r0 = gw; r0 < MT; r0 += 2 * nw) {
        u32x4 cv[3], pv[3], nv[3]; float raw[2]; int rr[3];
#pragma unroll
        for (int k = 0; k < 3; ++k) { cv[k] = cvn[k]; pv[k] = pvn[k]; nv[k] = nvn[k]; rr[k] = r0 + qk[k] * nw < MT ? r0 + qk[k] * nw : r0; }
        raw[0] = rawn[0]; raw[1] = rawn[1];
        if (r0 + 2 * nw < MT) load_rows(r0 + 2 * nw);
#pragma unroll
        for (int k = 0; k < 3; ++k) { if (r0 + qk[k] * nw >= MT) continue; u32x4 o; conv8_silu(pv[k], cv[k], nv[k], w[k], 1.f, o); *(u32x4*)(P + (size_t)rr[k] * 768 + ck[k]) = o; }
#pragma unroll
        for (int q = 0; q < 2; ++q) { const int r = r0 + q * nw; if (r >= MT) break;
            if (lane < 16) { const float dt = softplusf_(raw[q] + dtb); DT[(size_t)r * 32 + lane] = dt; DT[(size_t)r * 32 + 16 + lane] = dt * na; } }
    }
}
__device__ __forceinline__ void prep_mlstm(const Params& p, int l) {
    const int lane = otid() & 63, gw = blockIdx.x * 8 + __builtin_amdgcn_readfirstlane(otid() >> 6), nw = gridDim.x * 8;
    const bf16_t* U = (const bf16_t*)(p.ws + OFF_UM);
    bf16_t* P = (bf16_t*)(p.ws + OFF_PM); float* GM = (float*)(p.ws + OFF_GM); const bf16_t* UD = (const bf16_t*)(p.ws + OFF_UD);
    const float* cw = p.in[30] + l * 3 * 512; const float* cb = p.in[31] + l * 512;
    float w[32]; const int ck = lane * 8;
#pragma unroll
    for (int j = 0; j < 8; ++j) { w[j] = cw[ck + j]; w[8 + j] = cw[512 + ck + j]; w[16 + j] = cw[1024 + ck + j]; w[24 + j] = cb[ck + j]; }
    const float scale = ck >= 256 ? 0.125f : 1.f;
    float gb = 0.f; { const int d = lane >> 3, gi = (lane >> 2) & 1, hh = lane & 3; if (lane < 16) gb = gi == 0 ? p.in[32][(l * 2 + d) * 4 + hh] : p.in[33][(l * 2 + d) * 4 + hh]; }
    u32x4 cvn[2], pvn[2], nvn[2]; float rawn[2];
    auto load_rows = [&](int r0) {
#pragma unroll
        for (int q = 0; q < 2; ++q) { const int r = r0 + q * nw < MT ? r0 + q * nw : r0;
            int t, T; if (r < NCTX) { t = r & 255; T = 256; } else { t = (r - NCTX) & 4095; T = 4096; }
            const bf16_t* ur = U + (size_t)r * 512 + ck;
            cvn[q] = *(const u32x4*)ur; pvn[q] = *(const u32x4*)(ur - (t > 0 ? 512 : 0)); nvn[q] = *(const u32x4*)(ur + (t < T - 1 ? 512 : 0));
            if (t == 0) pvn[q] = (u32x4){0u, 0u, 0u, 0u}; if (t == T - 1) nvn[q] = (u32x4){0u, 0u, 0u, 0u};
            rawn[q] = lane < 16 ? bf2f(UD[(size_t)r * 256 + 16 + lane]) : 0.f; }
    };
    if (gw < MT) load_rows(gw);
    for (int r0 = gw; r0 < MT; r0 += 2 * nw) {
        u32x4 cv[2], pv[2], nv[2]; float raw[2];
#pragma unroll
        for (int q = 0; q < 2; ++q) { cv[q] = cvn[q]; pv[q] = pvn[q]; nv[q] = nvn[q]; raw[q] = rawn[q]; }
        if (r0 + 2 * nw < MT) load_rows(r0 + 2 * nw);
#pragma unroll
        for (int q = 0; q < 2; ++q) { const int r = r0 + q * nw; if (r >= MT) break;
            u32x4 o; conv8_silu(pv[q], cv[q], nv[q], w, scale, o); *(u32x4*)(P + (size_t)r * 768 + ck) = o;
            if (lane < 16) { const int d = lane >> 3, gi = (lane >> 2) & 1, hh = lane & 3;
                if (gi == 0) GM[(size_t)r * 16 + d * 8 + hh] = raw[q] + gb;
                else GM[(size_t)r * 16 + d * 8 + 4 + hh] = -softplusf_(-(raw[q] + gb)); } }
    }
}
typedef pg8::bf16x8 bf16x8;
constexpr int LDW = 72;
__device__ __forceinline__ bf16x8 ldfrag(const LAS bf16_t* b, int row, int k0) { return *(const LAS bf16x8*)(b + row * LDW + k0); }
__device__ __forceinline__ f32x4 mma(bf16x8 a, bf16x8 b, f32x4 c) { return __builtin_amdgcn_mfma_f32_16x16x32_bf16(a, b, c, 0, 0, 0); }
template <int CTRL> __device__ __forceinline__ float dppmov_old(float old, float x) { return __int_as_float(__builtin_amdgcn_update_dpp(__float_as_int(old), __float_as_int(x), CTRL, 0xF, 0xF, false)); }
__device__ __forceinline__ float wave_prefix_sum(float x, int lane) {
    x += dppmov_old<0x111>(0.f, x); x += dppmov_old<0x112>(0.f, x); x += dppmov_old<0x114>(0.f, x); x += dppmov_old<0x118>(0.f, x);
    const int xi = __float_as_int(x);
    const float t0 = __int_as_float(__builtin_amdgcn_readlane(xi, 15)), t1 = __int_as_float(__builtin_amdgcn_readlane(xi, 31)), t2 = __int_as_float(__builtin_amdgcn_readlane(xi, 47));
    const int rw = lane >> 4;
    return x + (rw == 0 ? 0.f : rw == 1 ? t0 : rw == 2 ? t0 + t1 : t0 + t1 + t2);
}
__device__ __forceinline__ float wave_prefix_max(float x, int lane) {
    const float ninf = -__builtin_inff();
    x = fmaxf(x, dppmov_old<0x111>(ninf, x)); x = fmaxf(x, dppmov_old<0x112>(ninf, x)); x = fmaxf(x, dppmov_old<0x114>(ninf, x)); x = fmaxf(x, dppmov_old<0x118>(ninf, x));
    const int xi = __float_as_int(x);
    const float t0 = __int_as_float(__builtin_amdgcn_readlane(xi, 15)), t1 = __int_as_float(__builtin_amdgcn_readlane(xi, 31)), t2 = __int_as_float(__builtin_amdgcn_readlane(xi, 47));
    const int rw = lane >> 4;
    return fmaxf(x, rw == 0 ? ninf : rw == 1 ? t0 : rw == 2 ? fmaxf(t0, t1) : fmaxf(fmaxf(t0, t1), t2));
}
template <int MODE> __device__ __forceinline__ void scan_chunked(const Params& p, int l, LAS unsigned char* lds, int lb0, int nlb, int cb0, int ncb) {
    constexpr int NPT = MODE ? 5 : 4, NH = MODE ? 4 : 8, NLONG = 8 * NH * 2, NCTXI = 32 * NH * 2;
    constexpr int SZ_T = 64 * LDW, SZ_V = 80 * LDW;
    const int tid = otid(), wid = __builtin_amdgcn_readfirstlane(tid >> 6), lane = tid & 63, fr = lane & 15, fq = lane >> 4;
    LAS bf16_t* Qb = (LAS bf16_t*)lds;
    LAS bf16_t* Kb = Qb + 2 * SZ_T;
    LAS bf16_t* KT = Kb + 2 * SZ_T;
    LAS bf16_t* VT = KT + 2 * SZ_T;
    LAS bf16_t* Sb = VT + 2 * SZ_V;
    LAS bf16_t* Wm = Sb + 2 * SZ_V;
    LAS float* sc = (LAS float*)(Wm + SZ_T);
    LAS float* eALp = sc + 2 * 5 * 64;
    LAS float* den = eALp + 4;
    const bf16_t* PS = (const bf16_t*)(p.ws + OFF_PS); const float* DT = (const float*)(p.ws + OFF_DT);
    const bf16_t* PM = (const bf16_t*)(p.ws + OFF_PM); const float* GM = (const float*)(p.ws + OFF_GM);
    bf16_t* O = (bf16_t*)(p.ws + (MODE ? OFF_OM : OFF_OS));
    const int tau_s = tid & 63, c8 = wid;
    for (int pass = 0; pass < 2; ++pass) {
        const int b0 = pass == 0 ? lb0 : cb0, nbk = pass == 0 ? nlb : ncb, itn = pass == 0 ? NLONG : NCTXI;
        if ((int)blockIdx.x < b0 || (int)blockIdx.x >= b0 + nbk) continue;
        for (int u = blockIdx.x - b0; u < itn; u += nbk) {
            const bool lat = pass == 0;
            const int d = u & 1, h = (u >> 1) & (NH - 1), b = u / (2 * NH), g = h >> 2;
            const int base = lat ? NCTX + b * 4096 : b * 256, T = lat ? 4096 : 256, NC = T / 64;
            const int sidx = ((b * 2 + l) * 2 + d) * NH + h;
            const float dsk = (MODE == 0 && d == 0) ? p.in[18][l * 8 + h] : 0.f;
            f32x4 st[2], stn = {0.f, 0.f, 0.f, 0.f};
            float m0 = 0.f;
            {
                const float* s0 = MODE ? p.in[4] : p.in[2];
#pragma unroll
                for (int e = 0; e < 2; ++e) { const int pt = wid >> 1, nt = (wid & 1) * 2 + e;
#pragma unroll
                    for (int i = 0; i < 4; ++i) { const int pp = pt * 16 + fq * 4 + i, nn = nt * 16 + fr;
                        st[e][i] = lat ? s0[((size_t)sidx * 64 + pp) * 64 + nn] : 0.f;
                        Sb[pp * LDW + nn] = f2bf(st[e][i]); } }
                if (MODE && wid >= 4) { const int nn = (wid - 4) * 16 + fr;
                    if (lat && fq == 0) stn[0] = p.in[5][(size_t)sidx * 64 + nn];
#pragma unroll
                    for (int i = 0; i < 4; ++i) Sb[(64 + fq * 4 + i) * LDW + nn] = f2bf(stn[i]); }
                if (MODE && lat) m0 = p.in[6][sidx];
                if (MODE) { for (int i = tid; i < 2 * 16 * 64; i += 512) { const int bsel = i >> 10, rr = (i >> 6) & 15, cc = i & 63; VT[bsel * SZ_V + (64 + rr) * LDW + cc] = rr == 0 ? (bf16_t)0x3F80 : (bf16_t)0; } }
            }
            u32x4 rq, rk, rv;
            auto tok = [&](int c, int tau) { const int step = c * 64 + tau; return base + (d ? T - 1 - step : step); };
            auto load_regs = [&](int c) {
                const size_t row = (size_t)tok(c, tau_s);
                if (MODE == 0) { const bf16_t* pr = PS + row * 768; rq = *(const u32x4*)(pr + 640 + g * 64 + c8 * 8); rk = *(const u32x4*)(pr + 512 + g * 64 + c8 * 8); rv = *(const u32x4*)(pr + h * 64 + c8 * 8); }
                else { const bf16_t* pr = PM + row * 768; rq = *(const u32x4*)(pr + h * 64 + c8 * 8); rk = *(const u32x4*)(pr + 256 + h * 64 + c8 * 8); rv = *(const u32x4*)(pr + 512 + h * 64 + c8 * 8); }
            };
            float sr0 = 0.f, sr1 = 0.f;
            auto load_scal = [&](int c) {
                const size_t row = (size_t)tok(c, lane);
                if (MODE == 0) { sr0 = DT[row * 32 + d * 8 + h]; sr1 = DT[row * 32 + 16 + d * 8 + h]; }
                else { sr0 = GM[row * 16 + d * 8 + h]; sr1 = GM[row * 16 + d * 8 + 4 + h]; }
            };
            auto scalars = [&](int c) {
                const int Y = c & 1; LAS float* s_ = sc + Y * 320;
                float A, beta, emm = 0.f;
                if (MODE == 0) { A = wave_prefix_sum(sr1, lane); beta = sr0; }
                else { const float ig = sr0, lf = sr1;
                    const float F = wave_prefix_sum(lf, lane), pm = wave_prefix_max(ig - F, lane), mx = fmaxf(m0, pm), mt = F + mx;
                    A = m0 - mx; beta = __expf(ig - mt); emm = __expf(-mt);
                    m0 = __int_as_float(__builtin_amdgcn_readlane(__float_as_int(mt), 63)); }
                const float AL = __int_as_float(__builtin_amdgcn_readlane(__float_as_int(A), 63));
                s_[lane] = A; s_[64 + lane] = __expf(A); s_[128 + lane] = beta; s_[192 + lane] = __expf(AL - A) * beta; s_[256 + lane] = emm;
                if (lane == 0) eALp[Y] = __expf(AL);
            };
            auto store_regs = [&](int c) {
                const int Y = c & 1;
                *(LAS u32x4*)(Qb + Y * SZ_T + tau_s * LDW + c8 * 8) = rq;
                *(LAS u32x4*)(Kb + Y * SZ_T + tau_s * LDW + c8 * 8) = rk;
                const float w = sc[Y * 320 + 192 + tau_s];
#pragma unroll
                for (int j = 0; j < 4; ++j) {
                    KT[Y * SZ_T + (c8 * 8 + 2 * j) * LDW + tau_s] = f2bf(bflo(rk[j]) * w); KT[Y * SZ_T + (c8 * 8 + 2 * j + 1) * LDW + tau_s] = f2bf(bfhi(rk[j]) * w);
                    VT[Y * SZ_V + (c8 * 8 + 2 * j) * LDW + tau_s] = (bf16_t)(rv[j] & 0xffff); VT[Y * SZ_V + (c8 * 8 + 2 * j + 1) * LDW + tau_s] = (bf16_t)(rv[j] >> 16);
                }
            };
            load_regs(0);
            if (wid == 0) { load_scal(0); scalars(0); if (NC > 1) load_scal(1); }
            __syncthreads();
            store_regs(0);
            __syncthreads();
            for (int c = 0; c < NC; ++c) {
                const int X = c & 1, Y = X ^ 1;
                const LAS bf16_t* Qx = Qb + X * SZ_T; const LAS bf16_t* Kx = Kb + X * SZ_T; const LAS bf16_t* KTx = KT + X * SZ_T; const LAS bf16_t* VTx = VT + X * SZ_V; const LAS bf16_t* Sx = Sb + X * SZ_V;
                const LAS float* sx = sc + X * 320;
                if (c + 1 < NC) { load_regs(c + 1); if (wid == 0) { scalars(c + 1); if (c + 2 < NC) load_scal(c + 2); } }
                const int tt = wid >> 1;
                const bf16x8 aq0 = ldfrag(Qx, tt * 16 + fr, fq * 8), aq1 = ldfrag(Qx, tt * 16 + fr, 32 + fq * 8);
#pragma unroll
                for (int e = 0; e < 2; ++e) { const int ts = (wid & 1) * 2 + e;
                    f32x4 gacc = {0.f, 0.f, 0.f, 0.f};
                    if (ts <= tt) { gacc = mma(aq0, ldfrag(Kx, ts * 16 + fr, fq * 8), gacc); gacc = mma(aq1, ldfrag(Kx, ts * 16 + fr, 32 + fq * 8), gacc); }
                    const int s_ = ts * 16 + fr; const float As = sx[s_], bs = sx[128 + s_];
#pragma unroll
                    for (int i = 0; i < 4; ++i) { const int t = tt * 16 + fq * 4 + i; const float v = s_ <= t ? gacc[i] * __expf(sx[t] - As) * bs : 0.f; Wm[t * LDW + s_] = f2bf(v); } }
                __syncthreads();
                const float eAL = eALp[X];
                float dn[4] = {1.f, 1.f, 1.f, 1.f};
                if (MODE) {
                    f32x4 intra = {0.f, 0.f, 0.f, 0.f}, inter = {0.f, 0.f, 0.f, 0.f};
                    intra = mma(ldfrag(Wm, tt * 16 + fr, fq * 8), ldfrag(VTx, 64 + fr, fq * 8), intra);
                    if (tt >= 2) intra = mma(ldfrag(Wm, tt * 16 + fr, 32 + fq * 8), ldfrag(VTx, 64 + fr, 32 + fq * 8), intra);
                    inter = mma(aq0, ldfrag(Sx, 64 + fr, fq * 8), inter); inter = mma(aq1, ldfrag(Sx, 64 + fr, 32 + fq * 8), inter);
#pragma unroll
                    for (int i = 0; i < 4; ++i) { const int t = tt * 16 + fq * 4 + i; const float dv = intra[i] + sx[64 + t] * inter[i];
                        dn[i] = rcpf_(fmaxf(fabsf(__shfl(dv, lane & 48)), sx[256 + t])); }
                    if (wid >= 4) { const int nt = wid - 4;
                        stn = stn * eAL;
                        stn = mma(ldfrag(VTx, 64 + fr, fq * 8), ldfrag(KTx, nt * 16 + fr, fq * 8), stn); stn = mma(ldfrag(VTx, 64 + fr, 32 + fq * 8), ldfrag(KTx, nt * 16 + fr, 32 + fq * 8), stn);
#pragma unroll
                        for (int i = 0; i < 4; ++i) Sb[Y * SZ_V + (64 + fq * 4 + i) * LDW + nt * 16 + fr] = f2bf(stn[i]); }
                }
#pragma unroll
                for (int e = 0; e < 2; ++e) { const int pt = wid >> 1, nt = (wid & 1) * 2 + e;
                    st[e] = st[e] * eAL;
                    st[e] = mma(ldfrag(VTx, pt * 16 + fr, fq * 8), ldfrag(KTx, nt * 16 + fr, fq * 8), st[e]); st[e] = mma(ldfrag(VTx, pt * 16 + fr, 32 + fq * 8), ldfrag(KTx, nt * 16 + fr, 32 + fq * 8), st[e]);
#pragma unroll
                    for (int i = 0; i < 4; ++i) Sb[Y * SZ_V + (pt * 16 + fq * 4 + i) * LDW + nt * 16 + fr] = f2bf(st[e][i]); }
                if (c + 1 < NC) store_regs(c + 1);
                {
                    const bf16x8 aw0 = ldfrag(Wm, tt * 16 + fr, fq * 8), aw1 = ldfrag(Wm, tt * 16 + fr, 32 + fq * 8);
                    constexpr int OST = MODE ? 512 : 1024;
                    bf16_t* ob = O + (size_t)tok(c, tt * 16 + fq * 4) * OST + d * (MODE ? 256 : 512) + h * 64 + fr; const int osi = d ? -OST : OST;
#pragma unroll
                    for (int e = 0; e < 2; ++e) { const int pt = (wid & 1) * 2 + e;
                        f32x4 intra = {0.f, 0.f, 0.f, 0.f}, inter = {0.f, 0.f, 0.f, 0.f};
                        intra = mma(aw0, ldfrag(VTx, pt * 16 + fr, fq * 8), intra);
                        if (tt >= 2) intra = mma(aw1, ldfrag(VTx, pt * 16 + fr, 32 + fq * 8), intra);
                        inter = mma(aq0, ldfrag(Sx, pt * 16 + fr, fq * 8), inter); inter = mma(aq1, ldfrag(Sx, pt * 16 + fr, 32 + fq * 8), inter);
                        const int pp = pt * 16 + fr;
#pragma unroll
                        for (int i = 0; i < 4; ++i) { const int t = tt * 16 + fq * 4 + i;
                            float o = intra[i] + sx[64 + t] * inter[i];
                            if (MODE == 0) { if (d == 0) o += dsk * bf2f(VTx[pp * LDW + t]); }
                            else o *= dn[i];
                            ob[i * osi + pt * 16] = f2bf(o); } }
                }
                __syncthreads();
            }
            if (!lat) {
                float* so = p.out + (MODE ? OS_MC : OS_SSD);
#pragma unroll
                for (int e = 0; e < 2; ++e) { const int pt = wid >> 1, nt = (wid & 1) * 2 + e;
#pragma unroll
                    for (int i = 0; i < 4; ++i) so[((size_t)sidx * 64 + pt * 16 + fq * 4 + i) * 64 + nt * 16 + fr] = st[e][i]; }
                if (MODE && wid >= 4 && fq == 0) p.out[OS_MN + (size_t)sidx * 64 + (wid - 4) * 16 + fr] = stn[0];
                if (MODE && tid == 0) p.out[OS_MM + sidx] = m0;
            }
        }
    }
}

__device__ __forceinline__ void post_phase(const Params& p, int l) {
    const int lane = otid() & 63, gw = blockIdx.x * 8 + __builtin_amdgcn_readfirstlane(otid() >> 6), nw = gridDim.x * 8;
    const bf16_t* OS = (const bf16_t*)(p.ws + OFF_OS); const bf16_t* ZS = (const bf16_t*)(p.ws + OFF_ZS);
    const bf16_t* OR_ = (const bf16_t*)(p.ws + OFF_OR); const bf16_t* GR = (const bf16_t*)(p.ws + OFF_GR);
    const bf16_t* OM = (const bf16_t*)(p.ws + OFF_OM); const bf16_t* OG = (const bf16_t*)(p.ws + OFF_OG);
    bf16_t* Y = (bf16_t*)(p.ws + OFF_H);
    const float* gs = p.in[19] + l * 512; const float* gr = p.in[29] + l * 256; const float* gm = p.in[34] + l * 256;
    float gsv[8], ggv2[2][4];
#pragma unroll
    for (int j = 0; j < 8; ++j) gsv[j] = gs[lane * 8 + j];
#pragma unroll
    for (int j = 0; j < 4; ++j) { ggv2[0][j] = gr[lane * 4 + j]; ggv2[1][j] = gm[lane * 4 + j]; }
    u32x4 yfn[2], ybn[2], zzn[2]; u32x2 ofn[2][2], obn[2][2], gxn[2][2];
    auto load_rows = [&](int r0) {
#pragma unroll
        for (int q = 0; q < 2; ++q) { const size_t r = r0 + q * nw < MT ? r0 + q * nw : r0;
            yfn[q] = *(const u32x4*)(OS + r * 1024 + lane * 8); ybn[q] = *(const u32x4*)(OS + r * 1024 + 512 + lane * 8); zzn[q] = *(const u32x4*)(ZS + r * 512 + lane * 8);
            ofn[q][0] = *(const u32x2*)(OR_ + r * 512 + lane * 4); obn[q][0] = *(const u32x2*)(OR_ + r * 512 + 256 + lane * 4); gxn[q][0] = *(const u32x2*)(GR + r * 256 + lane * 4);
            ofn[q][1] = *(const u32x2*)(OM + r * 512 + lane * 4); obn[q][1] = *(const u32x2*)(OM + r * 512 + 256 + lane * 4); gxn[q][1] = *(const u32x2*)(OG + r * 256 + lane * 4); }
    };
    if (gw < MT) load_rows(gw);
    for (int r0 = gw; r0 < MT; r0 += 2 * nw) {
        u32x4 yf[2], yb[2], zz[2]; u32x2 of[2][2], ob[2][2], gx[2][2];
#pragma unroll
        for (int q = 0; q < 2; ++q) { yf[q] = yfn[q]; yb[q] = ybn[q]; zz[q] = zzn[q];
#pragma unroll
            for (int m = 0; m < 2; ++m) { of[q][m] = ofn[q][m]; ob[q][m] = obn[q][m]; gx[q][m] = gxn[q][m]; } }
        if (r0 + 2 * nw < MT) load_rows(r0 + 2 * nw);
#pragma unroll
        for (int q = 0; q < 2; ++q) { const size_t r = r0 + q * nw; if (r >= (size_t)MT) break;
            {
                const int c = lane * 8;
                float y[8];
#pragma unroll
                for (int j = 0; j < 4; ++j) { y[2 * j] = (bflo(yf[q][j]) + bflo(yb[q][j])) * bflo(zz[q][j]); y[2 * j + 1] = (bfhi(yf[q][j]) + bfhi(yb[q][j])) * bfhi(zz[q][j]); }
                float ss = 0.f;
#pragma unroll
                for (int j = 0; j < 8; ++j) ss += y[j] * y[j];
#pragma unroll
                for (int o = 1; o < 32; o <<= 1) ss += __shfl_xor(ss, o);
                const float rstd = rsqrtf(ss * (1.f / 256.f) + 1e-5f);
                u32x4 w;
#pragma unroll
                for (int j = 0; j < 4; ++j) w[j] = pk2(y[2 * j] * rstd * gsv[2 * j], y[2 * j + 1] * rstd * gsv[2 * j + 1]);
                *(u32x4*)(Y + r * 1024 + c) = w;
            }
#pragma unroll
            for (int mx = 0; mx < 2; ++mx) {
                const int c = lane * 4;
                float v[4] = {bflo(of[q][mx].x) + bflo(ob[q][mx].x), bfhi(of[q][mx].x) + bfhi(ob[q][mx].x), bflo(of[q][mx].y) + bflo(ob[q][mx].y), bfhi(of[q][mx].y) + bfhi(ob[q][mx].y)};
                float sm_ = v[0] + v[1] + v[2] + v[3];
                sm_ = row_allreduce<16>(sm_);
                const float mean = sm_ * (1.f / 64.f);
                float ss = 0.f;
#pragma unroll
                for (int j = 0; j < 4; ++j) { v[j] -= mean; ss += v[j] * v[j]; }
                ss = row_allreduce<16>(ss);
                const float rstd = rsqrtf(ss * (1.f / 64.f) + 1e-5f);
                const float* gg = mx == 0 ? gr : gm;
                float gt[4] = {bflo(gx[q][mx].x), bfhi(gx[q][mx].x), bflo(gx[q][mx].y), bfhi(gx[q][mx].y)};
                u32x2 w; w.x = pk2(v[0] * rstd * ggv2[mx][0] * gt[0], v[1] * rstd * ggv2[mx][1] * gt[1]); w.y = pk2(v[2] * rstd * ggv2[mx][2] * gt[2], v[3] * rstd * ggv2[mx][3] * gt[3]);
                *(u32x2*)(Y + r * 1024 + 512 + mx * 256 + c) = w;
            }
        }
    }
}

constexpr int NSUB = 12, NPHASE = 2 + 2 * NSUB;
__device__ __forceinline__ void run_phase(const Params& p, int ph, unsigned char* shm) {
    LAS unsigned char* lds = (LAS unsigned char*)shm;
    if (ph == 0) { prologue_phase(p, (float*)shm); return; }
    if (ph == NPHASE - 1) { norm_phase(p, 0, 2, 0, MT, (const bf16_t*)(p.ws + OFF_H)); return; }
    const int l = (ph - 1) / NSUB, sub = (ph - 1) % NSUB;
    const bf16_t* H = (const bf16_t*)(p.ws + OFF_H);
    const float* modl = (const float*)(p.ws + OFF_MOD) + (size_t)l * 9 * 6144;
    switch (sub) {
    case 0: norm_phase(p, l, 0); break;
    case 1: { EpiStoreBf16 E{(bf16_t*)(p.ws + OFF_UR), NR}; run_gemm(lds, H, (const bf16_t*)(p.ws + OFF_WR) + (size_t)l * NR * 1024, NR, 1024, E); } break;
    case 2: prep_rwkv(p, l, (float*)shm); break;
    case 3: scan_rwkv<16>(p, l, (LAS float*)lds); scan_rwkv<8>(p, l, (LAS float*)lds); break;
    case 4: { EpiSM E{EpiSSD{(bf16_t*)(p.ws + OFF_ZS), (bf16_t*)(p.ws + OFF_US), (bf16_t*)(p.ws + OFF_UD)}, EpiMLSTM{(bf16_t*)(p.ws + OFF_UM), (bf16_t*)(p.ws + OFF_PM), (bf16_t*)(p.ws + OFF_OG)}};
        run_gemm(lds, H, (const bf16_t*)(p.ws + OFF_WS) + (size_t)l * NSM * 1024, NSM, 1024, E); } break;
    case 5: prep_ssd(p, l); prep_mlstm(p, l); break;
    case 6: {
        const bool g256 = gridDim.x >= 256;
        scan_chunked<0>(p, l, lds, 0, g256 ? 128 : (int)gridDim.x, g256 ? 192 : 0, g256 ? (int)gridDim.x - 192 : (int)gridDim.x);
        scan_chunked<1>(p, l, lds, g256 ? 128 : 0, g256 ? 64 : (int)gridDim.x, g256 ? 192 : 0, g256 ? (int)gridDim.x - 192 : (int)gridDim.x); } break;
    case 7: post_phase(p, l); break;
    case 8: case 11: {
        const bool ffn = sub == 11;
        EpiResidual E{p.in[0], p.in[1], (!ffn && l == 0) ? 1 : 0, (bf16_t*)p.out, modl + (ffn ? 5120 : 2048), (ffn && l == 1) ? (bf16_t*)(p.ws + OFF_H) : (bf16_t*)p.out};
        const bf16_t* A = ffn ? (const bf16_t*)(p.ws + OFF_ACT) : H;
        const bf16_t* Bt = ffn ? (const bf16_t*)(p.ws + OFF_W2) + (size_t)l * 1024 * 2816 : (const bf16_t*)(p.ws + OFF_WO) + (size_t)l * 1024 * 1024;
        run_gemm(lds, A, Bt, 1024, ffn ? 2816 : 1024, E); } break;
    case 9: norm_phase(p, l, 1); break;
    case 10: { EpiSwiglu E{(bf16_t*)(p.ws + OFF_ACT)}; run_gemm(lds, H, (const bf16_t*)(p.ws + OFF_W13) + (size_t)l * 5632 * 1024, 5632, 1024, E); } break;
    }
}
__global__ __launch_bounds__(512, 2) void mega(Params p) {
    extern __shared__ __attribute__((aligned(16))) unsigned char shm[];
    cg::grid_group grid = cg::this_grid();
    volatile LAS unsigned* st = (volatile LAS unsigned*)((LAS unsigned char*)shm + 131072);
    XcdBarrier xb; xb.bar = (unsigned*)(p.ws + OFF_BAR); xb.x = 0; xb.st = st;
    if (p.ph_hi - p.ph_lo > 1) {
        if (threadIdx.x < 4) st[threadIdx.x] = 0u;
        __syncthreads();
        xb = xcd_barrier_post((unsigned*)(p.ws + OFF_BAR), st);
    }
    int nsync = 0;
    for (int ph = p.ph_lo; ph < p.ph_hi; ++ph) {
        int reps = 1;
#ifdef PROBE_MASK
        if (ph > 0 && ph < NPHASE - 1 && ((PROBE_MASK >> ((ph - 1) % NSUB)) & 1)) reps += PROBE_REPS;
#endif
#ifdef PROBE_P0
        if (ph == 0) reps += PROBE_P0;
#endif
        for (int rep = 0; rep < reps; ++rep) {
            if (ph > p.ph_lo || rep > 0) { if (p.ph_lo < 0) grid.sync(); else xcd_barrier(xb); ++nsync; }
            run_phase(p, ph, shm);
        }
#ifdef PROBE_EMPTY
        if (ph == 1) { for (int k = 0; k < PROBE_EMPTY; ++k) xcd_barrier(xb); }
#endif
    }
}
}

extern "C" void kernel_launch(void* const* d_in, const int* in_sizes, int n_in, void* d_out, int out_size, void* d_ws, size_t ws_size, hipStream_t stream) {
    static int grid = 0;
    if (grid == 0) {
        if (n_in != 40 || ws_size < mk::WS_END2) { fprintf(stderr, "kernel_launch: need 40 inputs and %zu bytes of workspace (got %d, %zu)\n", (size_t)mk::WS_END2, n_in, ws_size); grid = -1; return; }
        int dev = 0, cus = 0, per_cu = 0;
        hipGetDevice(&dev); hipDeviceGetAttribute(&cus, hipDeviceAttributeMultiprocessorCount, dev);
        if (hipFuncSetAttribute((const void*)mk::mega, hipFuncAttributeMaxDynamicSharedMemorySize, mk::LDS_BYTES) != hipSuccess) { fprintf(stderr, "kernel_launch: hipFuncSetAttribute failed\n"); }
        if (hipOccupancyMaxActiveBlocksPerMultiprocessor(&per_cu, (const void*)mk::mega, 512, mk::LDS_BYTES) != hipSuccess || per_cu < 1) per_cu = 1;
        (void)hipGetLastError();
        grid = cus * 1;
    }
    if (grid < 0) return;
    if (hipMemsetAsync((char*)d_ws + mk::OFF_BAR, 0, 16384, stream) != hipSuccess) { fprintf(stderr, "kernel_launch: memset of the barrier words failed\n"); return; }
    mk::Params p{};
    for (int i = 0; i < 40; ++i) p.in[i] = (const float*)d_in[i];
    p.out = (float*)d_out; p.ws = (unsigned char*)d_ws;
#if ONE_LAUNCH
    p.ph_lo = 0; p.ph_hi = mk::NPHASE;
    void* args[] = {&p};
    hipError_t e = hipLaunchCooperativeKernel((const void*)mk::mega, dim3(grid), dim3(512), args, mk::LDS_BYTES, stream);
    if (e != hipSuccess) fprintf(stderr, "cooperative launch failed: %s (grid %d)\n", hipGetErrorString(e), grid);
#else
    for (int ph = 0; ph < mk::NPHASE; ++ph) {
        p.ph_lo = ph; p.ph_hi = ph + 1;
        hipLaunchKernelGGL(mk::mega, dim3(grid), dim3(512), mk::LDS_BYTES, stream, p);
    }
#endif
}
```

```cpp
#include <hip/hip_runtime.h>
#include <hip/hip_cooperative_groups.h>
#include <cstdio>
namespace cg = cooperative_groups;
#ifndef ONE_LAUNCH
#define ONE_LAUNCH 1
#endif
namespace pg8 {
#define PG8_LAS __attribute__((address_space(3)))
typedef unsigned short bf16_t;
typedef short bf16x8 __attribute__((ext_vector_type(8)));
typedef float f32x4 __attribute__((ext_vector_type(4)));
typedef unsigned u32x4 __attribute__((ext_vector_type(4)));
constexpr int BM = 256, BK = 64, HALF = 128, HTB = HALF * BK * 2  , STAGE_BYTES = 8 * HTB, NXCD = 8, WGM = 8;

__host__ __device__ __forceinline__ int lds_byte(int r, int c) { const int st = (r >> 4) * 2 + (c >> 5), rr = r & 15, cc = c & 31, ob = rr * 64 + cc * 2; return st * 1024 + (ob ^ (((ob >> 9) & 1) << 5)); }
__host__ __device__ __forceinline__ void stage_rc(int b, int& R, int& C) { const int st = b / 1024, sb = b % 1024, swz = sb ^ (((sb >> 9) & 1) << 5); R = (st >> 1) * 16 + swz / 64; C = (st & 1) * 32 + (swz % 64) / 2; }
__host__ __device__ __forceinline__ int perm32(int rho) { const int n = rho >> 4, i = rho & 15; return 8 * (i >> 2) + 4 * n + (i & 3); }

struct Unit { int pm, pn; };
struct Gemm { const bf16_t* A; const bf16_t* Bt; int M, N, K; };

struct StaticOrder {
    int nM, nN, nwg, G, c;
    __host__ __device__ void init(int M, int N, int G_, int c_) { nM = M / BM; nN = N / BM; nwg = nM * nN; G = G_; c = c_; }
    __host__ __device__ bool next(int i, Unit& u) const {
        const long L = (long)i * G + c; if (L >= nwg) return false;
        int wgid = (int)L; { const int q = nwg / NXCD, r = nwg % NXCD, xcd = wgid % NXCD, off = wgid / NXCD; wgid = (xcd < r ? xcd * (q + 1) : r * (q + 1) + (xcd - r) * q) + off; }
        const int nig = WGM * nN, gid = wgid / nig, fm = gid * WGM, gsz = (nM - fm) < WGM ? (nM - fm) : WGM;
        u.pm = fm + ((wgid % nig) % gsz); u.pn = (wgid % nig) / gsz; return true;
    }
    __device__ __forceinline__ void a_ready(const Unit&) const {}
    __device__ __forceinline__ void done(const Unit&) const {}
};
__device__ __forceinline__ unsigned cvt_pk_bf16(float lo, float hi) { unsigned r; asm volatile("v_cvt_pk_bf16_f32 %0, %1, %2" : "=v"(r) : "v"(lo), "v"(hi)); return r; }
template <class Epi, class Sched, bool STAMP = false>
__device__ __forceinline__ void gemm_phase(PG8_LAS unsigned char* lds, const Gemm g, const Sched& S, const Epi& E, unsigned long long* stamps) {
    int tid_l = threadIdx.x; asm volatile("" : "+v"(tid_l));
    const int tid = tid_l, wid = __builtin_amdgcn_readfirstlane(tid >> 6), lane = tid & 63, wr = wid >> 2, wc = wid & 3, fr = lane & 15, fq = lane >> 4;
    const int K = g.K, nt = K / BK;
    int ts_lo = 0, ts_hi = 0, nts = 0; const unsigned long long rt_entry = STAMP ? (unsigned long long)wall_clock64() : 0ull;
#define PG8_STAMP() do { if (STAMP && wid == 0 && nts < 64) { const unsigned long long _c = (unsigned long long)clock64(); \
        ts_lo = (lane == nts) ? (int)(unsigned)_c : ts_lo; ts_hi = (lane == nts) ? (int)(unsigned)(_c >> 32) : ts_hi; ++nts; } } while (0)
    PG8_STAMP();
    unsigned voffA[2], voffB[2];
#pragma unroll
    for (int i = 0; i < 2; ++i) { int R, C; stage_rc(tid * 16 + i * 8192, R, C); const int Rb = Epi::PERM ? ((R & ~31) + perm32(R & 31)) : R;
        voffA[i] = (unsigned)(R * K + C) * 2u; voffB[i] = (unsigned)(Rb * K + C) * 2u; }
    const size_t kstep = (size_t)(BK * 2);
    const size_t hstep = (size_t)HALF * K * 2;
    const size_t tstep = 2 * hstep;
    const unsigned ldsw = (unsigned)wid * 1024u;
    const int aoff = lds_byte(wr * 64 + fr, fq * 8), boff = lds_byte(wc * 32 + fr, fq * 8);
#define PG8_SA(b, h) (((b) * 2 + (h)) * HTB)
#define PG8_SB(b, h) ((4 + (b) * 2 + (h)) * HTB)
#define PG8_STAGE(bufoff, gbase, voff) do { _Pragma("unroll") for (int _i = 0; _i < 2; ++_i) \
        __builtin_amdgcn_global_load_lds((const unsigned*)((const char*)(gbase) + (voff)[_i]), (PG8_LAS unsigned*)(lds + (bufoff) + ldsw + _i * 8192), 16, 0, 0); } while (0)
#define PG8_LDA(dst, b, h) do { _Pragma("unroll") for (int m = 0; m < 4; ++m) _Pragma("unroll") for (int k = 0; k < 2; ++k) dst[m][k] = *(const PG8_LAS bf16x8*)(lds + PG8_SA(b, h) + aoff + m * 2048 + k * 1024); } while (0)
#define PG8_LDB(dst, b, h) do { _Pragma("unroll") for (int n = 0; n < 2; ++n) _Pragma("unroll") for (int k = 0; k < 2; ++k) dst[n][k] = *(const PG8_LAS bf16x8*)(lds + PG8_SB(b, h) + boff + n * 2048 + k * 1024); } while (0)
#define PG8_MMA(ai, bj, At, Bt) do { __builtin_amdgcn_s_setprio(1); _Pragma("unroll") for (int m = 0; m < 4; ++m) _Pragma("unroll") for (int n = 0; n < 2; ++n) _Pragma("unroll") for (int k = 0; k < 2; ++k) \
        acc[ai][bj][m][n] = __builtin_amdgcn_mfma_f32_16x16x32_bf16(Bt[n][k], At[m][k], acc[ai][bj][m][n], 0, 0, 0); __builtin_amdgcn_s_setprio(0); } while (0)
#define PG8_WAIT_V(n) asm volatile("s_waitcnt vmcnt(" #n ")" ::: "memory")
#define PG8_WAIT_L(n) asm volatile("s_waitcnt lgkmcnt(" #n ")" ::: "memory")
#define PG8_BAR __builtin_amdgcn_s_barrier()
#define PG8_SCHED __builtin_amdgcn_sched_barrier(0)
    Unit cur, nxt; int ui = 0;
    if (!S.next(0, cur)) return;
    f32x4 acc[2][2][4][2];
#pragma unroll
    for (int a = 0; a < 2; ++a)
#pragma unroll
        for (int b = 0; b < 2; ++b)
#pragma unroll
            for (int m = 0; m < 4; ++m)
#pragma unroll
                for (int n = 0; n < 2; ++n) acc[a][b][m][n] = (f32x4){0.f, 0.f, 0.f, 0.f};
    bf16x8 At[4][2], B0[2][2], B1[2][2];
    const char* cA = (const char*)g.A + (size_t)cur.pm * tstep; const char* cB = (const char*)g.Bt + (size_t)cur.pn * tstep;
    S.a_ready(cur);
    PG8_STAGE(PG8_SB(0, 0), cB, voffB); PG8_STAGE(PG8_SA(0, 0), cA, voffA); PG8_STAGE(PG8_SB(0, 1), cB + hstep, voffB); PG8_STAGE(PG8_SA(0, 1), cA + hstep, voffA);
    if (wr == 1) PG8_BAR;
    PG8_WAIT_V(4); PG8_BAR;
    PG8_STAGE(PG8_SB(1, 0), cB + kstep, voffB); PG8_STAGE(PG8_SA(1, 0), cA + kstep, voffA); PG8_STAGE(PG8_SB(1, 1), cB + hstep + kstep, voffB);
    PG8_WAIT_V(6); PG8_BAR;
    PG8_STAMP();
    for (;;) {
        const bool has_next = S.next(ui + 1, nxt);
        const char* nA = has_next ? (const char*)g.A + (size_t)nxt.pm * tstep : cA; const char* nB = has_next ? (const char*)g.Bt + (size_t)nxt.pn * tstep : cB;
        for (int t = 0; t < nt; t += 2) {
            const bool last = (t == nt - 2);
            const char* a1 = cA + (size_t)(t + 1) * kstep;
            const char* a2 = last ? nA : cA + (size_t)(t + 2) * kstep; const char* b2 = last ? nB : cB + (size_t)(t + 2) * kstep;
            const char* a3 = a2 + kstep; const char* b3 = b2 + kstep;
            if (last && has_next) S.a_ready(nxt);
            PG8_LDB(B0, 0, 0); PG8_SCHED; PG8_LDA(At, 0, 0); PG8_STAGE(PG8_SA(1, 1), a1 + hstep, voffA);
            PG8_WAIT_L(8); PG8_BAR; PG8_WAIT_L(0); PG8_MMA(0, 0, At, B0); PG8_BAR; PG8_SCHED;
            PG8_LDB(B1, 0, 1); PG8_STAGE(PG8_SB(0, 0), b2, voffB);
            PG8_BAR; PG8_WAIT_L(0); PG8_MMA(0, 1, At, B1); PG8_BAR;
            PG8_LDA(At, 0, 1); PG8_STAGE(PG8_SA(0, 0), a2, voffA);
            PG8_BAR; PG8_WAIT_L(0); PG8_MMA(1, 0, At, B0); PG8_BAR; PG8_SCHED;
            PG8_STAGE(PG8_SB(0, 1), b2 + hstep, voffB);
            PG8_WAIT_V(6); PG8_BAR; PG8_MMA(1, 1, At, B1); PG8_BAR;
            PG8_LDB(B0, 1, 0); PG8_SCHED; PG8_LDA(At, 1, 0); PG8_STAGE(PG8_SA(0, 1), a2 + hstep, voffA);
            PG8_WAIT_L(8); PG8_BAR; PG8_WAIT_L(0); PG8_MMA(0, 0, At, B0); PG8_BAR; PG8_SCHED;
            PG8_LDB(B1, 1, 1); PG8_STAGE(PG8_SB(1, 0), b3, voffB);
            PG8_BAR; PG8_WAIT_L(0); PG8_MMA(0, 1, At, B1); PG8_BAR;
            PG8_LDA(At, 1, 1); PG8_STAGE(PG8_SA(1, 0), a3, voffA);
            PG8_BAR; PG8_WAIT_L(0); PG8_MMA(1, 0, At, B0); PG8_BAR; PG8_SCHED;
            PG8_STAGE(PG8_SB(1, 1), b3 + hstep, voffB);
            PG8_WAIT_V(6); PG8_BAR; PG8_MMA(1, 1, At, B1); PG8_BAR;
        }
        PG8_STAMP();
        if constexpr (!Epi::AFTER_DRAIN) { E(acc, cur, wr, wc, fr, fq); S.done(cur); }
        PG8_STAMP();
        if (!has_next) break;
#pragma unroll
        for (int a = 0; a < 2; ++a)
#pragma unroll
            for (int b = 0; b < 2; ++b)
#pragma unroll
                for (int m = 0; m < 4; ++m)
#pragma unroll
                    for (int n = 0; n < 2; ++n) acc[a][b][m][n] = (f32x4){0.f, 0.f, 0.f, 0.f};
        cur = nxt; cA = nA; cB = nB; ++ui;
    }
    PG8_WAIT_V(0);
    if (wr == 0) PG8_BAR;
    PG8_BAR;
    if constexpr (Epi::AFTER_DRAIN) { E.fused(acc, cur, wr, wc, fr, fq, lds, wid, lane); S.done(cur); }
    PG8_STAMP();
    if (STAMP && wid == 0) { stamps[lane] = lane < nts ? (((unsigned long long)(unsigned)ts_hi << 32) | (unsigned)ts_lo) : 0ull;
        if (lane == 62) stamps[62] = rt_entry; if (lane == 63) stamps[63] = (unsigned long long)wall_clock64(); }
#undef PG8_STAMP
#undef PG8_SA
#undef PG8_SB
#undef PG8_STAGE
#undef PG8_LDA
#undef PG8_LDB
#undef PG8_MMA
#undef PG8_WAIT_V
#undef PG8_WAIT_L
#undef PG8_BAR
#undef PG8_SCHED
}
}
#define XB_TMO      128
#define XB_XCNT(j)  (256  + 64 * (j))
#define XB_XSUB(j)  (1280 + 64 * (j))
#define XB_XGEN(j)  (2304 + 64 * (j))
#define XB_TOP      3328
#define XB_TOPGEN   3392
#define XCD_BAR_WORDS 3456
#define XB_SPIN_CAP (1u << 18)
#define LAS __attribute__((address_space(3)))

__device__ __forceinline__ unsigned xb_ld(unsigned* p)              { return __hip_atomic_load(p, __ATOMIC_RELAXED, __HIP_MEMORY_SCOPE_AGENT); }
__device__ __forceinline__ unsigned xb_add(unsigned* p, unsigned v) { return __hip_atomic_fetch_add(p, v, __ATOMIC_RELAXED, __HIP_MEMORY_SCOPE_AGENT); }
__device__ __forceinline__ unsigned xb_xcc_id() { return (unsigned)__builtin_amdgcn_s_getreg((3 << 11) | 20) & 0xFu; }
#define XB_SPIN(cond, bar) do { unsigned _sp = 0; while (cond) { __builtin_amdgcn_s_sleep(1); \
    if ((++_sp & 255u) == 0u) { if (xb_ld(&(bar)[XB_TMO])) break; if (_sp > XB_SPIN_CAP) { atomicAdd(&(bar)[XB_TMO], 1u); break; } } } } while (0)

struct XcdBarrier {
    unsigned* bar; unsigned x;
    volatile LAS unsigned* st;
};

__device__ __forceinline__ XcdBarrier xcd_barrier_post(unsigned* bar, volatile LAS unsigned* st) {
    XcdBarrier b; b.bar = bar; b.x = xb_xcc_id(); b.st = st;
    if (threadIdx.x == 0) (void)xb_add(&bar[XB_XCNT(b.x)], 1u);
    return b;
}
__device__ __forceinline__ void xcd_barrier_complete(unsigned* bar, unsigned x, unsigned& nloc, unsigned& nx) {
    const unsigned G = gridDim.x * gridDim.y * gridDim.z;
    unsigned sum, cnt, mine, sp = 0u;
    for (;;) {
        sum = 0u; cnt = 0u; mine = 0u;
#pragma unroll
        for (unsigned j = 0; j < 16; ++j) { const unsigned c = xb_ld(&bar[XB_XCNT(j)]); sum += c; cnt += (c > 0u) ? 1u : 0u; mine = (j == x) ? c : mine; }
        if (sum == G) break;
        __builtin_amdgcn_s_sleep(1);
        if ((++sp & 255u) == 0u) { if (xb_ld(&bar[XB_TMO])) break; if (sp > XB_SPIN_CAP) { atomicAdd(&bar[XB_TMO], 1u); break; } }
    }
    nloc = mine > 0u ? mine : 1u; nx = cnt > 0u ? cnt : 1u;
}

__device__ __forceinline__ void xcd_barrier(const XcdBarrier& b) {
    asm volatile("s_waitcnt vmcnt(0)" ::: "memory");
    __syncthreads();
    if (threadIdx.x == 0) {
        unsigned* bar = b.bar;
        __builtin_amdgcn_s_waitcnt(0);
        unsigned nloc = b.st[0], nx = b.st[1];
        if (nloc == 0u) { xcd_barrier_complete(bar, b.x, nloc, nx); b.st[0] = nloc; b.st[1] = nx; }
        const unsigned old = xb_add(&bar[XB_XSUB(b.x)], 1u);
        const unsigned gen = old / nloc;
        if (old + 1u == (gen + 1u) * nloc) {
            __builtin_amdgcn_fence(__ATOMIC_RELEASE, "agent");
            asm volatile("s_waitcnt vmcnt(0)" ::: "memory");
            const unsigned og = xb_add(&bar[XB_TOP], 1u);
            const unsigned tg = og / nx;
            if (og + 1u == (tg + 1u) * nx) xb_add(&bar[XB_TOPGEN], 1u);
            else XB_SPIN(xb_ld(&bar[XB_TOPGEN]) == tg, bar);
            __builtin_amdgcn_fence(__ATOMIC_ACQUIRE, "agent");
            xb_add(&bar[XB_XGEN(b.x)], 1u);
            asm volatile("s_waitcnt vmcnt(0)" ::: "memory");
        } else {
            XB_SPIN(xb_ld(&bar[XB_XGEN(b.x)]) == gen, bar);
            __builtin_amdgcn_fence(__ATOMIC_ACQUIRE, "agent");
            asm volatile("s_waitcnt vmcnt(0)" ::: "memory");
        }
    }
    __syncthreads();
}
namespace mk {
using pg8::bf16_t; using pg8::f32x4; using pg8::u32x4; using pg8::Unit;
#define LAS __attribute__((address_space(3)))
typedef unsigned u32x2 __attribute__((ext_vector_type(2)));
constexpr int MT = 40960, NCTX = 8192;
constexpr int NR = 1024, NS = 1536, NM = 1024;
constexpr int NSM = NS + NM;
constexpr size_t SZ_WR = 2ull * NR * 1024 * 2, SZ_WS = 2ull * NSM * 1024 * 2, SZ_WM = 0, SZ_WO = 2ull * 1024 * 1024 * 2, SZ_W13 = 2ull * 5632 * 1024 * 2, SZ_W2 = 2ull * 1024 * 2816 * 2;
constexpr size_t OFF_WR = 0, OFF_WS = OFF_WR + SZ_WR, OFF_WM = OFF_WS + SZ_WS, OFF_WO = OFF_WM + SZ_WM, OFF_W13 = OFF_WO + SZ_WO, OFF_W2 = OFF_W13 + SZ_W13, OFF_MOD = OFF_W2 + SZ_W2;
constexpr size_t SZ_MOD = 2ull * 9 * 6144 * 4;
constexpr size_t COLB = (size_t)MT * 2;
constexpr size_t OFF_LW = OFF_MOD + SZ_MOD, SZ_LW = 2ull * (4 * 256 * 32 + 256 * 64) * 2;
constexpr size_t OFF_H = OFF_LW + SZ_LW, OFF_OR = OFF_H + 1024 * COLB, OFF_GR = OFF_OR + 512 * COLB, OFF_BIG = OFF_GR + 256 * COLB;
constexpr size_t OFF_UR = OFF_BIG, OFF_PR = OFF_BIG + 1024 * COLB;
constexpr size_t OFF_ZS = OFF_BIG, OFF_PS = OFF_BIG + 512 * COLB, OFF_DT = OFF_BIG + 1280 * COLB, OFF_PM = OFF_BIG + 1344 * COLB, OFF_GM = OFF_BIG + 2112 * COLB, OFF_OG = OFF_BIG + 2144 * COLB;
constexpr size_t OFF_SH = OFF_BIG + 2400 * COLB;
constexpr size_t OFF_UD = OFF_SH + 768 * COLB;
constexpr size_t OFF_US = OFF_SH, OFF_UM = OFF_SH + 1024 * COLB, OFF_OS = OFF_SH, OFF_OM = OFF_SH + 1024 * COLB;
constexpr size_t OFF_ACT = OFF_BIG;
constexpr size_t WS_END = OFF_BIG + 3936 * COLB;
constexpr size_t OS_SSD = 41943040ull, OS_RWKV = OS_SSD + 4194304ull, OS_MC = OS_RWKV + 2097152ull, OS_MN = OS_MC + 2097152ull, OS_MM = OS_MN + 32768ull;
constexpr size_t OFF_BAR = WS_END, WS_END2 = OFF_BAR + 16384;
constexpr int LDS_BYTES = 131072 + 16;

struct Params { const float* in[40]; float* out; unsigned char* ws; int ph_lo, ph_hi; };

__device__ __forceinline__ int otid() { int t = threadIdx.x; asm volatile("" : "+v"(t)); return t; }
__device__ __forceinline__ float bf2f(unsigned v) { return __uint_as_float(v << 16); }
__device__ __forceinline__ float bflo(unsigned w) { return __uint_as_float(w << 16); }
__device__ __forceinline__ float bfhi(unsigned w) { return __uint_as_float(w & 0xffff0000u); }
typedef __bf16 bf16x2_t __attribute__((ext_vector_type(2)));
typedef float f32x2_t __attribute__((ext_vector_type(2)));
__device__ __forceinline__ unsigned pk2(float lo, float hi) { const f32x2_t v = {lo, hi}; const bf16x2_t b = __builtin_convertvector(v, bf16x2_t); return __builtin_bit_cast(unsigned, b); }
__device__ __forceinline__ bf16_t f2bf(float f) { const __bf16 b = (__bf16)f; return __builtin_bit_cast(unsigned short, b); }
__device__ __forceinline__ float rcpf_(float x) { return __builtin_amdgcn_rcpf(x); }
__device__ __forceinline__ float sigmoidf_(float x) { return rcpf_(1.f + __expf(-x)); }
__device__ __forceinline__ float siluf_(float x) { return x * rcpf_(1.f + __expf(-x)); }
__device__ __forceinline__ float softplusf_(float x) { return fmaxf(x, 0.f) + log1pf(__expf(-fabsf(x))); }
__device__ __forceinline__ float softplus_fast(float x) { return fmaxf(x, 0.f) + __logf(1.f + __expf(-fabsf(x))); }
__device__ __forceinline__ float tanhf_(float x) { return 1.f - 2.f * rcpf_(__expf(2.f * x) + 1.f); }
template <int CTRL> __device__ __forceinline__ float dppmov(float x) { return __int_as_float(__builtin_amdgcn_update_dpp(0, __float_as_int(x), CTRL, 0xF, 0xF, true)); }
template <int LPR> __device__ __forceinline__ float row_allreduce(float x) {
    x += dppmov<0xB1>(x); x += dppmov<0x4E>(x); x += dppmov<0x141>(x);
    if (LPR == 16) x += dppmov<0x140>(x);
    return x;
}
__device__ __forceinline__ float wave_sum(float x) {
    x = row_allreduce<16>(x);
    const int xi = __float_as_int(x);
    return __int_as_float(__builtin_amdgcn_readlane(xi, 0)) + __int_as_float(__builtin_amdgcn_readlane(xi, 16)) + __int_as_float(__builtin_amdgcn_readlane(xi, 32)) + __int_as_float(__builtin_amdgcn_readlane(xi, 48));
}
__device__ __forceinline__ const float* xsrc_row(const Params& p, int l, int r) {
    if (l == 0) return r < NCTX ? p.in[0] + (size_t)r * 1024 : p.in[1] + (size_t)(r - NCTX) * 1024;
    return p.out + (size_t)r * 1024;
}
__device__ __forceinline__ int cond_of_row(int r) { return r < NCTX ? 0 : 1 + ((r - NCTX) >> 12); }

__device__ __forceinline__ void transpose_job(const float* src, int K, int Nsrc, int c0, int ncols, int Npad, bf16_t* dst, int mode, float* tile, int xlo = 0, int xcnt = 0, int xc0 = 0) {
    const int tid = otid(), lane = tid & 63, w = __builtin_amdgcn_readfirstlane(tid >> 6);
    const int nkt = K / 64, nnt = Npad / 64, nit = nkt * nnt;
    for (int it0 = blockIdx.x; it0 < nit; it0 += 2 * gridDim.x) {
        float v[2][8];
#pragma unroll
        for (int h = 0; h < 2; ++h) { const int it = it0 + h * gridDim.x; if (it < nit) {
            const int kt = it / nnt, nt = it % nnt, k0 = kt * 64, n = nt * 64 + lane;
            const int scol = (n >= xlo && n < xlo + xcnt) ? xc0 + (n - xlo) : (n < ncols ? c0 + n : -1);
#pragma unroll
            for (int i = 0; i < 8; ++i) v[h][i] = scol >= 0 ? __builtin_nontemporal_load(src + (size_t)(k0 + w + 8 * i) * Nsrc + scol) : 0.f; } }
#pragma unroll
        for (int h = 0; h < 2; ++h) { if (it0 + h * gridDim.x < nit) {
#pragma unroll
            for (int i = 0; i < 8; ++i) tile[h * 64 * 65 + (w + 8 * i) * 65 + lane] = v[h][i]; } }
        __syncthreads();
#pragma unroll
        for (int h = 0; h < 2; ++h) { const int it = it0 + h * gridDim.x; if (it < nit) {
            const int kt = it / nnt, nt = it % nnt, k0 = kt * 64, n0 = nt * 64;
            const int nn = tid >> 3, kc = (tid & 7) * 8, ng = n0 + nn;
            const int drow = mode == 0 ? ng : ((ng >> 7) * 256 + (ng & 127) + (mode == 2 ? 128 : 0));
            const float* t = tile + h * 64 * 65;
            u32x4 o;
            o.x = pk2(t[(kc + 0) * 65 + nn], t[(kc + 1) * 65 + nn]); o.y = pk2(t[(kc + 2) * 65 + nn], t[(kc + 3) * 65 + nn]);
            o.z = pk2(t[(kc + 4) * 65 + nn], t[(kc + 5) * 65 + nn]); o.w = pk2(t[(kc + 6) * 65 + nn], t[(kc + 7) * 65 + nn]);
            *(u32x4*)(dst + (size_t)drow * K + k0 + kc) = o; } }
        __syncthreads();
    }
}
__device__ __forceinline__ void prologue_phase(const Params& p, float* sm) {
    for (int l = 0; l < 2; ++l) {
        const float* win = p.in[13] + (size_t)l * 1024 * 3296;
        transpose_job(win, 1024, 3296, 1296, 960, NR, (bf16_t*)(p.ws + OFF_WR) + (size_t)l * NR * 1024, 0, sm);
        transpose_job(win, 1024, 3296, 0, 1296, NS, (bf16_t*)(p.ws + OFF_WS) + (size_t)l * NSM * 1024, 0, sm, 1296, 16, 3280);
        transpose_job(win, 1024, 3296, 2256, 1024, NM, (bf16_t*)(p.ws + OFF_WS) + ((size_t)l * NSM + NS) * 1024, 0, sm);
        transpose_job(p.in[35] + (size_t)l * 1024 * 1024, 1024, 1024, 0, 1024, 1024, (bf16_t*)(p.ws + OFF_WO) + (size_t)l * 1024 * 1024, 0, sm);
        transpose_job(p.in[36] + (size_t)l * 1024 * 2816, 1024, 2816, 0, 2816, 2816, (bf16_t*)(p.ws + OFF_W13) + (size_t)l * 5632 * 1024, 1, sm);
        transpose_job(p.in[37] + (size_t)l * 1024 * 2816, 1024, 2816, 0, 2816, 2816, (bf16_t*)(p.ws + OFF_W13) + (size_t)l * 5632 * 1024, 2, sm);
        transpose_job(p.in[38] + (size_t)l * 2816 * 1024, 2816, 1024, 0, 1024, 1024, (bf16_t*)(p.ws + OFF_W2) + (size_t)l * 1024 * 2816, 0, sm);
    }
    {
        bf16_t* LW = (bf16_t*)(p.ws + OFF_LW);
        for (int i = blockIdx.x * 512 + otid(); i < 2 * 49152; i += gridDim.x * 512) {
            const int l = i / 49152, j = i % 49152;
            float v;
            if (j < 32768) { const int mat = j >> 13, c = (j >> 5) & 255, k = j & 31; v = (mat < 2 ? p.in[22] : p.in[24])[((size_t)(l * 2 + (mat & 1)) * 32 + k) * 256 + c]; }
            else { const int jj = j - 32768, c = jj >> 6, k = jj & 63; v = p.in[25][((size_t)l * 64 + k) * 256 + c]; }
            LW[i] = f2bf(v);
        }
    }
    const int tid = otid(), lane = tid & 63, kg = __builtin_amdgcn_readfirstlane(tid >> 6);
    float* red = sm + 9 * 1024;
    for (int i = tid; i < 9 * 1024; i += 512) { const int ci = i >> 10, k = i & 1023; const float v = ci == 0 ? p.in[8][k] : p.in[7][(ci - 1) * 1024 + k]; sm[i] = siluf_(v); }
    __syncthreads();
    float* mod = (float*)(p.ws + OFF_MOD);
    for (int it = blockIdx.x; it < 192; it += gridDim.x) {
        const int l = it / 96, nb = (it % 96) * 64;
        const float* W = p.in[9] + (size_t)l * 1024 * 6144 + nb + lane;
        float acc[9];
#pragma unroll
        for (int ci = 0; ci < 9; ++ci) acc[ci] = 0.f;
#pragma unroll 8
        for (int k = kg * 128; k < kg * 128 + 128; ++k) {
            const float w = __builtin_nontemporal_load(W + (size_t)k * 6144);
#pragma unroll
            for (int ci = 0; ci < 9; ++ci) acc[ci] += sm[ci * 1024 + k] * w;
        }
#pragma unroll
        for (int ci = 0; ci < 9; ++ci) red[(kg * 9 + ci) * 64 + lane] = acc[ci];
        __syncthreads();
        for (int i = tid; i < 576; i += 512) {
            const int ci = i >> 6, ln = i & 63; float s = 0.f;
            for (int g = 0; g < 8; ++g) s += red[(g * 9 + ci) * 64 + ln];
            mod[(size_t)(l * 9 + ci) * 6144 + nb + ln] = s + p.in[10][l * 6144 + nb + ln];
        }
        __syncthreads();
    }
}

__device__ __forceinline__ void norm_phase(const Params& p, int l, int which, int rlo = 0, int rhi = MT, const bf16_t* xsrc = nullptr, bf16_t* tmp = nullptr) {
    constexpr int NRW = 2;
    const int lane = otid() & 63, gw = blockIdx.x * 8 + __builtin_amdgcn_readfirstlane(otid() >> 6), nw = gridDim.x * 8;
    const float* g = which >= 2 ? p.in[39] : p.in[which ? 12 : 11] + l * 1024;
    const float* mod = (const float*)(p.ws + OFF_MOD) + (size_t)l * 9 * 6144;
    bf16_t* H = (bf16_t*)(p.ws + OFF_H);
    const bf16_t* XB = xsrc ? xsrc : (const bf16_t*)p.out;
    const bool f32src = which == 0 && l == 0;
    const int sh_off = which ? 3072 : 0, sc_off = which ? 4096 : 1024;
    auto load_rows = [&](int r0, f32x4 (&v)[NRW][4]) {
#pragma unroll
        for (int q = 0; q < NRW; ++q) { const int r = r0 + q * nw < rhi ? r0 + q * nw : r0;
            if (f32src) { const float* x = xsrc_row(p, 0, r);
#pragma unroll
                for (int j = 0; j < 4; ++j) v[q][j] = ((const f32x4*)x)[lane + 64 * j]; }
            else { const bf16_t* x = XB + (size_t)r * 1024;
#pragma unroll
                for (int j = 0; j < 2; ++j) { const u32x4 w = *(const u32x4*)(x + (lane + 64 * j) * 8);
                    v[q][2 * j] = (f32x4){bflo(w.x), bfhi(w.x), bflo(w.y), bfhi(w.y)}; v[q][2 * j + 1] = (f32x4){bflo(w.z), bfhi(w.z), bflo(w.w), bfhi(w.w)}; } } }
    };
    f32x4 ggv[4];
#pragma unroll
    for (int j = 0; j < 4; ++j) ggv[j] = *(const f32x4*)(g + (f32src ? (lane + 64 * j) * 4 : (lane + 64 * (j >> 1)) * 8 + (j & 1) * 4));
    f32x4 vn[NRW][4];
    if (rlo + gw < rhi) load_rows(rlo + gw, vn);
    for (int r0 = rlo + gw; r0 < rhi; r0 += NRW * nw) {
        f32x4 v[NRW][4]; float ss[NRW];
#pragma unroll
        for (int q = 0; q < NRW; ++q)
#pragma unroll
            for (int j = 0; j < 4; ++j) v[q][j] = vn[q][j];
        if (r0 + NRW * nw < rhi) load_rows(r0 + NRW * nw, vn);
        if (which == 3) {
#pragma unroll
            for (int q = 0; q < NRW; ++q) { const int r = r0 + q * nw; if (r >= rhi) break;
#pragma unroll
                for (int j = 0; j < 2; ++j) { u32x4 w; w.x = pk2(v[q][2 * j].x, v[q][2 * j].y); w.y = pk2(v[q][2 * j].z, v[q][2 * j].w); w.z = pk2(v[q][2 * j + 1].x, v[q][2 * j + 1].y); w.w = pk2(v[q][2 * j + 1].z, v[q][2 * j + 1].w);
                    *(u32x4*)(tmp + (size_t)r * 1024 + (lane + 64 * j) * 8) = w; } }
            continue;
        }
#pragma unroll
        for (int q = 0; q < NRW; ++q) { float s = 0.f;
#pragma unroll
            for (int j = 0; j < 4; ++j) s += v[q][j].x * v[q][j].x + v[q][j].y * v[q][j].y + v[q][j].z * v[q][j].z + v[q][j].w * v[q][j].w;
            ss[q] = wave_sum(s); }
#pragma unroll
        for (int q = 0; q < NRW; ++q) { const int r = r0 + q * nw; if (r >= rhi) break;
            const float rstd = rsqrtf(ss[q] * (1.f / 1024.f) + 1e-6f);
            const float* mc = mod + cond_of_row(r) * 6144;
#pragma unroll
            for (int j = 0; j < 4; ++j) {
                const int col = f32src ? (lane + 64 * j) * 4 : (lane + 64 * (j >> 1)) * 8 + (j & 1) * 4;
                const f32x4 gg = ggv[j];
                if (which == 2) { *(f32x4*)(p.out + (size_t)r * 1024 + col) = v[q][j] * rstd * gg; }
                else { const f32x4 sc = *(const f32x4*)(mc + sc_off + col), sh = *(const f32x4*)(mc + sh_off + col);
                    const f32x4 o = v[q][j] * rstd * gg * (sc + 1.f) + sh;
                    u32x2 w; w.x = pk2(o.x, o.y); w.y = pk2(o.z, o.w);
                    *(u32x2*)(H + (size_t)r * 1024 + col) = w; }
            } }
    }
}

struct EpiStoreBf16 {
    static constexpr bool PERM = true, AFTER_DRAIN = false;
    bf16_t* O; int ldc;
    __device__ __forceinline__ void operator()(const f32x4 (&acc)[2][2][4][2], const Unit& u, int wr, int wc, int fr, int fq) const {
        const int row0 = u.pm * 256 + wr * 64 + fr, col0 = u.pn * 256 + wc * 32 + 8 * fq;
#pragma unroll
        for (int ai = 0; ai < 2; ++ai)
#pragma unroll
            for (int m = 0; m < 4; ++m) { bf16_t* rowp = O + (size_t)(row0 + ai * 128 + m * 16) * ldc + col0;
#pragma unroll
                for (int bj = 0; bj < 2; ++bj) { const f32x4 v0 = acc[ai][bj][m][0], v1 = acc[ai][bj][m][1];
                    u32x4 w; w.x = pk2(v0[0], v0[1]); w.y = pk2(v0[2], v0[3]); w.z = pk2(v1[0], v1[1]); w.w = pk2(v1[2], v1[3]);
                    *(u32x4*)(rowp + bj * 128) = w; } }
    }
};
template <int ACT> __device__ __forceinline__ void store_tile_bf16(const f32x4 (&acc)[2][2][4][2], bf16_t* O, int ldc, int cb, int row0) {
#pragma unroll
    for (int ai = 0; ai < 2; ++ai)
#pragma unroll
        for (int m = 0; m < 4; ++m) { bf16_t* rowp = O + (size_t)(row0 + ai * 128 + m * 16) * ldc + cb;
#pragma unroll
            for (int bj = 0; bj < 2; ++bj) { f32x4 v0 = acc[ai][bj][m][0], v1 = acc[ai][bj][m][1];
                if (ACT) {
#pragma unroll
                    for (int j = 0; j < 4; ++j) { const float s0 = rcpf_(1.f + __expf(-v0[j])), s1 = rcpf_(1.f + __expf(-v1[j])); v0[j] = ACT == 1 ? v0[j] * s0 : s0; v1[j] = ACT == 1 ? v1[j] * s1 : s1; } }
                u32x4 w; w.x = pk2(v0[0], v0[1]); w.y = pk2(v0[2], v0[3]); w.z = pk2(v1[0], v1[1]); w.w = pk2(v1[2], v1[3]);
                *(u32x4*)(rowp + bj * 128) = w; }
            asm volatile("" ::: "memory"); }
}
struct EpiSSD {
    static constexpr bool PERM = true, AFTER_DRAIN = false;
    bf16_t* Zs; bf16_t* UC; bf16_t* UD;
    __device__ __forceinline__ void operator()(const f32x4 (&acc)[2][2][4][2], const Unit& u, int wr, int wc, int fr, int fq) const {
        const int row0 = u.pm * 256 + wr * 64 + fr, cin = wc * 32 + 8 * fq;
        if (u.pn < 2) store_tile_bf16<1>(acc, Zs, 512, u.pn * 256 + cin, row0);
        else if (u.pn < 5) store_tile_bf16<0>(acc, UC, 768, (u.pn - 2) * 256 + cin, row0);
        else store_tile_bf16<0>(acc, UD, 256, cin, row0);
    }
};
struct EpiMLSTM {
    static constexpr bool PERM = true, AFTER_DRAIN = false;
    bf16_t* UC; bf16_t* PM; bf16_t* OG;
    __device__ __forceinline__ void operator()(const f32x4 (&acc)[2][2][4][2], const Unit& u, int wr, int wc, int fr, int fq) const {
        const int row0 = u.pm * 256 + wr * 64 + fr, cin = wc * 32 + 8 * fq;
        if (u.pn < 2) store_tile_bf16<0>(acc, UC, 512, u.pn * 256 + cin, row0);
        else if (u.pn == 2) store_tile_bf16<0>(acc, PM + 512, 768, cin, row0);
        else store_tile_bf16<2>(acc, OG, 256, cin, row0);
    }
};
struct EpiSM {
    static constexpr bool PERM = true, AFTER_DRAIN = false;
    EpiSSD es; EpiMLSTM em;
    __device__ __forceinline__ void operator()(const f32x4 (&acc)[2][2][4][2], const Unit& u, int wr, int wc, int fr, int fq) const {
        if (u.pn < 6) es(acc, u, wr, wc, fr, fq);
        else { Unit v; v.pm = u.pm; v.pn = u.pn - 6; em(acc, v, wr, wc, fr, fq); }
    }
};
struct EpiSwiglu {
    static constexpr bool PERM = true, AFTER_DRAIN = false;
    bf16_t* O;
    __device__ __forceinline__ void operator()(const f32x4 (&acc)[2][2][4][2], const Unit& u, int wr, int wc, int fr, int fq) const {
        const int row0 = u.pm * 256 + wr * 64 + fr, col0 = u.pn * 128 + wc * 32 + 8 * fq;
#pragma unroll
        for (int ai = 0; ai < 2; ++ai)
#pragma unroll
            for (int m = 0; m < 4; ++m) { bf16_t* rowp = O + (size_t)(row0 + ai * 128 + m * 16) * 2816 + col0;
                f32x4 a[2];
#pragma unroll
                for (int n = 0; n < 2; ++n) { const f32x4 g = acc[ai][0][m][n], up = acc[ai][1][m][n];
#pragma unroll
                    for (int j = 0; j < 4; ++j) a[n][j] = g[j] * rcpf_(1.f + __expf(-g[j])) * up[j]; }
                u32x4 w; w.x = pk2(a[0][0], a[0][1]); w.y = pk2(a[0][2], a[0][3]); w.z = pk2(a[1][0], a[1][1]); w.w = pk2(a[1][2], a[1][3]);
                *(u32x4*)rowp = w;
                asm volatile("" ::: "memory"); }
    }
};
struct EpiResidual {
    static constexpr bool PERM = true, AFTER_DRAIN = false;
    const float* xp; const float* xs; int from_inputs; bf16_t* xb; const float* gate; bf16_t* xo;
    __device__ __forceinline__ void operator()(const f32x4 (&acc)[2][2][4][2], const Unit& u, int wr, int wc, int fr, int fq) const {
        const int rb = u.pm * 256, row0 = rb + wr * 64 + fr, col0 = u.pn * 256 + wc * 32 + 8 * fq;
        const float* gp = gate + cond_of_row(rb) * 6144 + col0;
        f32x4 gq[2][2];
#pragma unroll
        for (int bj = 0; bj < 2; ++bj) { gq[bj][0] = *(const f32x4*)(gp + bj * 128); gq[bj][1] = *(const f32x4*)(gp + bj * 128 + 4); }
#pragma unroll
        for (int ai = 0; ai < 2; ++ai)
#pragma unroll
            for (int m = 0; m < 4; ++m) { const int r = row0 + ai * 128 + m * 16;
                bf16_t* op = xb + (size_t)r * 1024 + col0; bf16_t* wp = xo + (size_t)r * 1024 + col0;
#pragma unroll
                for (int bj = 0; bj < 2; ++bj) { f32x4 r0v, r1v;
                    if (from_inputs) { const float* res = (r < NCTX ? xp + (size_t)r * 1024 : xs + (size_t)(r - NCTX) * 1024) + col0 + bj * 128; r0v = *(const f32x4*)res; r1v = *(const f32x4*)(res + 4); }
                    else { const u32x4 w = *(const u32x4*)(op + bj * 128); r0v = (f32x4){bflo(w.x), bfhi(w.x), bflo(w.y), bfhi(w.y)}; r1v = (f32x4){bflo(w.z), bfhi(w.z), bflo(w.w), bfhi(w.w)}; }
                    const f32x4 g0 = gq[bj][0], g1 = gq[bj][1];
                    const f32x4 o0 = r0v + g0 * acc[ai][bj][m][0], o1 = r1v + g1 * acc[ai][bj][m][1];
                    u32x4 w; w.x = pk2(o0.x, o0.y); w.y = pk2(o0.z, o0.w); w.z = pk2(o1.x, o1.y); w.w = pk2(o1.z, o1.w);
                    *(u32x4*)(wp + bj * 128) = w; }
                asm volatile("" ::: "memory"); }
    }
};
template <class Epi> __device__ __forceinline__ void run_gemm(LAS unsigned char* lds, const bf16_t* A, const bf16_t* Bt, int N, int K, const Epi& E) {
    pg8::Gemm g{A, Bt, MT, N, K}; pg8::StaticOrder S; S.init(MT, N, (int)gridDim.x, (int)blockIdx.x);
    pg8::gemm_phase<Epi, pg8::StaticOrder, false>(lds, g, S, E, nullptr);
}
__device__ __forceinline__ void prep_rwkv(const Params& p, int l, float* sm) {
    const int tid = otid(), lane = tid & 63, wid = __builtin_amdgcn_readfirstlane(tid >> 6);
    const bf16_t* U = (const bf16_t*)(p.ws + OFF_UR);
    bf16_t* P = (bf16_t*)(p.ws + OFF_PR);
    bf16_t* G = (bf16_t*)(p.ws + OFF_GR);
    const float* mu = p.in[20] + l * 960;
    float* um = sm; float* rs = sm + 16 * 960;
    bf16_t* actb = (bf16_t*)(sm + 16 * 960 + 64);
    const bf16_t* LW = (const bf16_t*)(p.ws + OFF_LW) + (size_t)l * 49152;
    const int fr = lane & 15, fq = lane >> 4;
    const int c = tid & 255, half = tid >> 8;
    const float kkc = p.in[26][l * 256 + c];
    pg8::bf16x8 bw[10][2];
#pragma unroll
    for (int jj = 0; jj < 10; ++jj) { const int job = wid * 10 + jj, mat = job >> 4, nt = job & 15;
        if (mat < 4) { bw[jj][0] = *(const pg8::bf16x8*)(LW + ((size_t)(mat * 256 + nt * 16 + fr)) * 32 + fq * 8); bw[jj][1] = bw[jj][0]; }
        else { const bf16_t* g = LW + 32768 + (size_t)(nt * 16 + fr) * 64 + fq * 8; bw[jj][0] = *(const pg8::bf16x8*)g; bw[jj][1] = *(const pg8::bf16x8*)(g + 32); } }
    float biasr[10];
#pragma unroll
    for (int jj = 0; jj < 10; ++jj) { const int job = wid * 10 + jj, mat = job >> 4, cc = (job & 15) * 16 + fr, d = mat & 1;
        biasr[jj] = mat < 2 ? p.in[21][(l * 2 + d) * 256 + cc] : mat < 4 ? p.in[23][(l * 2 + d) * 256 + cc] : 0.f; }
    const int chm = tid & 127, c0m = (chm < 120 ? chm : 119) * 8;
    const f32x4 mu0 = *(const f32x4*)(mu + c0m), mu1 = *(const f32x4*)(mu + c0m + 4);
    f32x4 kkm0 = {0.f, 0.f, 0.f, 0.f}, kkm1 = {0.f, 0.f, 0.f, 0.f};
    if (c0m >= 256 && c0m < 512) { kkm0 = *(const f32x4*)(p.in[26] + l * 256 + (c0m - 256)); kkm1 = *(const f32x4*)(p.in[26] + l * 256 + (c0m - 256) + 4); }
    const f32x4 kks0 = *(const f32x4*)(p.in[26] + l * 256 + (tid & 31) * 8), kks1 = *(const f32x4*)(p.in[26] + l * 256 + (tid & 31) * 8 + 4);
    for (int tile = blockIdx.x; tile < MT / 16; tile += gridDim.x) {
        const int r0 = tile * 16;
        {
            const bool ctx = r0 < NCTX;
#pragma unroll 1
            for (int bt = 0; bt < 2; ++bt) {
                u32x4 own[2], nb[2][4];
#pragma unroll
                for (int k = 0; k < 2; ++k) {
                    const int item = (bt * 2 + k) * 512 + tid, tk = item >> 7, ch = item & 127, chc = ch < 120 ? ch : 119, r = r0 + tk;
                    const bf16_t* ur = U + (size_t)r * 1024 + chc * 8;
                    own[k] = *(const u32x4*)ur;
                    if (ctx) { const int t = r & 255; nb[k][0] = *(const u32x4*)(ur + (t > 0 ? -1024 : 0)); nb[k][1] = *(const u32x4*)(ur + (t < 255 ? 1024 : 0)); nb[k][2] = nb[k][0]; nb[k][3] = nb[k][1]; }
                    else { const int t = (r - NCTX) & 4095, gx = t & 63, gy = t >> 6;
                        nb[k][0] = *(const u32x4*)(ur + (gx > 0 ? -1024 : 0)); nb[k][1] = *(const u32x4*)(ur + (gx < 63 ? 1024 : 0));
                        nb[k][2] = *(const u32x4*)(ur + (gy > 0 ? -65536 : 0)); nb[k][3] = *(const u32x4*)(ur + (gy < 63 ? 65536 : 0)); }
                }
#pragma unroll
                for (int k = 0; k < 2; ++k) {
                    const int item = (bt * 2 + k) * 512 + tid, tk = item >> 7, ch = item & 127, r = r0 + tk;
                    float ssq = 0.f;
                    if (ch < 120) {
                        const int c0 = ch * 8;
                        bool v0, v1, v2, v3;
                        if (ctx) { const int t = r & 255; v0 = t > 0; v1 = t < 255; v2 = v0; v3 = v1; }
                        else { const int t = (r - NCTX) & 4095, gx = t & 63, gy = t >> 6; v0 = gx > 0; v1 = gx < 63; v2 = gy > 0; v3 = gy < 63; }
                        float m[8];
#pragma unroll
                        for (int j = 0; j < 4; ++j) {
                            const int n0 = (j & 1) ? 2 : 0, n1 = (j & 1) ? 3 : 1;
                            const float u0 = bflo(own[k][j]), u1 = bfhi(own[k][j]);
                            const float s0 = ((j & 1) ? v2 : v0) ? bflo(nb[k][n0][j]) : 0.f, s1 = ((j & 1) ? v3 : v1) ? bfhi(nb[k][n1][j]) : 0.f;
                            const float mua = j < 2 ? mu0[2 * j] : mu1[2 * j - 4], mub = j < 2 ? mu0[2 * j + 1] : mu1[2 * j - 3];
                            m[2 * j] = u0 + (s0 - u0) * mua; m[2 * j + 1] = u1 + (s1 - u1) * mub;
                        }
                        if (c0 >= 768 && c0 < 832) {
#pragma unroll
                            for (int j = 0; j < 8; ++j) m[j] = tanhf_(m[j]); }
                        else if (c0 >= 896) {
#pragma unroll
                            for (int j = 0; j < 8; ++j) m[j] = sigmoidf_(m[j]); }
                        *(f32x4*)(um + tk * 960 + c0) = (f32x4){m[0], m[1], m[2], m[3]}; *(f32x4*)(um + tk * 960 + c0 + 4) = (f32x4){m[4], m[5], m[6], m[7]};
                        if (c0 >= 256 && c0 < 512) {
#pragma unroll
                            for (int j = 0; j < 8; ++j) { const float t = m[j] * (j < 4 ? kkm0[j] : kkm1[j - 4]); ssq += t * t; } }
                        if (c0 >= 768) { u32x4 w; w.x = pk2(m[0], m[1]); w.y = pk2(m[2], m[3]); w.z = pk2(m[4], m[5]); w.w = pk2(m[6], m[7]); *(u32x4*)(actb + tk * 200 + (c0 - 768)) = w; }
                    }
                    ssq = row_allreduce<8>(ssq);
                    if (ch >= 32 && ch < 64 && (ch & 7) == 0) rs[tk * 4 + ((ch - 32) >> 3)] = rsqrtf(ssq + 1e-12f);
                }
            }
        }
        __syncthreads();
#pragma unroll
        for (int it = 0; it < 4; ++it) {
            const int item = it * 512 + tid;
            int tk, c0; bool iskk = item >= 1536;
            if (!iskk) { tk = item / 96; c0 = (item % 96) * 8; } else { tk = (item - 1536) >> 5; c0 = 256 + ((item - 1536) & 31) * 8; }
            f32x4 a = *(const f32x4*)(um + tk * 960 + c0), b2 = *(const f32x4*)(um + tk * 960 + c0 + 4);
            if (iskk) { const float sc = rs[tk * 4 + ((c0 - 256) >> 6)]; a = a * kks0 * sc; b2 = b2 * kks1 * sc; }
            u32x4 w; w.x = pk2(a.x, a.y); w.y = pk2(a.z, a.w); w.z = pk2(b2.x, b2.y); w.w = pk2(b2.z, b2.w);
            *(u32x4*)(P + (size_t)(r0 + tk) * 2048 + (iskk ? 768 + (c0 - 256) : c0)) = w;
        }
        {
#pragma unroll
            for (int jj = 0; jj < 10; ++jj) { const int job = wid * 10 + jj, mat = job >> 4, nt = job & 15, cc = nt * 16 + fr;
                f32x4 acc = {0.f, 0.f, 0.f, 0.f};
                const pg8::bf16x8 a0 = *(const pg8::bf16x8*)(actb + fr * 200 + (mat < 4 ? mat * 32 : 128) + fq * 8);
                acc = __builtin_amdgcn_mfma_f32_16x16x32_bf16(a0, bw[jj][0], acc, 0, 0, 0);
                if (mat == 4) { const pg8::bf16x8 a1 = *(const pg8::bf16x8*)(actb + fr * 200 + 160 + fq * 8); acc = __builtin_amdgcn_mfma_f32_16x16x32_bf16(a1, bw[jj][1], acc, 0, 0, 0); }
                const int d = mat & 1;
                const float bias = biasr[jj];
#pragma unroll
                for (int i = 0; i < 4; ++i) { const size_t row = (size_t)(r0 + fq * 4 + i); const float z = acc[i] + bias;
                    if (mat < 2) { const float x = 0.60653066f * sigmoidf_(z); P[row * 2048 + 1536 + d * 256 + cc] = f2bf(1.f - __expf(-x)); }
                    else if (mat < 4) P[row * 2048 + 1024 + d * 256 + cc] = f2bf(sigmoidf_(z));
                    else G[row * 256 + cc] = f2bf(z); }
            }
        }
        __syncthreads();
    }
}

template <int LPR> __device__ __forceinline__ void scan_rwkv(const Params& p, int l, LAS float* lds) {
    constexpr int REC = 388, SLAB = 32, EPL = 64 / LPR, RPW = 64 / LPR, RPB = 4 * RPW, UPI = 64 / RPB, NV = EPL / 4;
    const int tid = otid(), wid = __builtin_amdgcn_readfirstlane(tid >> 6), lane = tid & 63, lr = lane & (LPR - 1);
    const bf16_t* P = (const bf16_t*)(p.ws + OFF_PR);
    bf16_t* O = (bf16_t*)(p.ws + OFF_OR);
    const bool lat = LPR == 16;
    const int nunits = (lat ? 64 : 256) * UPI;
    for (int uu = blockIdx.x; uu < nunits; uu += gridDim.x) {
        const int q = (uu >> 3) & (UPI - 1), item = (uu & 7) | ((uu / (8 * UPI)) << 3);
        const int d = item & 1, h = (item >> 1) & 3, b = item >> 3;
        const int base = lat ? NCTX + b * 4096 : b * 256, T = lat ? 4096 : 256, nslab = T / SLAB;
        const int irow = q * RPB + (wid & 3) * RPW + lane / LPR;
        f32x4 s[NV];
#pragma unroll
        for (int v = 0; v < NV; ++v) s[v] = (f32x4){0.f, 0.f, 0.f, 0.f};
        if (wid < 4 && lat) {
#pragma unroll
            for (int v = 0; v < NV; ++v) s[v] = *(const f32x4*)(p.in[3] + ((size_t)(((b * 2 + l) * 2 + d) * 4 + h) * 64 + irow) * 64 + lr * EPL + 4 * v); }
        const float ka = p.in[27][l * 256 + h * 64 + lane], rk1 = 1.f + p.in[28][l * 256 + h * 64 + lane];
        unsigned ra[8][6];
        auto issue = [&](int sl, unsigned (&raw)[8][6]) {
            const int pw = wid - 4;
#pragma unroll
            for (int j = 0; j < 8; ++j) {
                const int step = sl * SLAB + pw * 8 + j, t = d ? T - 1 - step : step;
                const bf16_t* pr = P + (size_t)(base + t) * 2048 + h * 64 + lane;
                raw[j][0] = pr[0]; raw[j][1] = pr[256]; raw[j][2] = pr[512]; raw[j][3] = pr[768]; raw[j][4] = pr[1024 + d * 256]; raw[j][5] = pr[1536 + d * 256];
            }
        };
        auto finish = [&](int sl, const unsigned (&raw)[8][6]) {
            const int pw = wid - 4;
#pragma unroll
            for (int j = 0; j < 8; ++j) {
                const int js = pw * 8 + j;
                const float r = bf2f(raw[j][0]), k = bf2f(raw[j][1]), v = bf2f(raw[j][2]), kk = bf2f(raw[j][3]), a = bf2f(raw[j][4]), omw = bf2f(raw[j][5]);
                const float w = 1.f - omw, bb = a * kk, kd = k * (1.f + (a - 1.f) * ka), wr = w * r;
                const float br = wave_sum(bb * r), c1 = wave_sum(kd * r * rk1);
                LAS float* rec = lds + ((sl & 1) * SLAB + js) * REC;
                rec[lane] = w; rec[64 + lane] = bb; rec[128 + lane] = kd; rec[192 + lane] = kk; rec[256 + lane] = wr; rec[320 + lane] = v;
                if (lane == 0) { rec[384] = br; rec[385] = c1; }
            }
        };
        auto consume = [&](int sl) {
            const LAS float* rbp = lds + (sl & 1) * SLAB * REC;
            f32x4 w4n[NV], b4n[NV], kd4n[NV], kk4n[NV], wr4n[NV];
#pragma unroll
            for (int v = 0; v < NV; ++v) { const int o = lr * EPL + 4 * v;
                w4n[v] = *(const LAS f32x4*)(rbp + o); b4n[v] = *(const LAS f32x4*)(rbp + 64 + o); kd4n[v] = *(const LAS f32x4*)(rbp + 128 + o); kk4n[v] = *(const LAS f32x4*)(rbp + 192 + o); wr4n[v] = *(const LAS f32x4*)(rbp + 256 + o); }
            float vin = rbp[320 + irow], brn = rbp[384], c1n = rbp[385];
            float ybuf = 0.f;
#pragma unroll(LPR == 16 ? 8 : 4)
            for (int j = 0; j < SLAB; ++j) {
                f32x4 w4[NV], b4[NV], kd4[NV], kk4[NV], wr4[NV];
#pragma unroll
                for (int v = 0; v < NV; ++v) { w4[v] = w4n[v]; b4[v] = b4n[v]; kd4[v] = kd4n[v]; kk4[v] = kk4n[v]; wr4[v] = wr4n[v]; }
                const float vi = vin, br = brn, c1 = c1n;
                if (j + 1 < SLAB) { const LAS float* rec = rbp + (j + 1) * REC;
#pragma unroll
                    for (int v = 0; v < NV; ++v) { const int o = lr * EPL + 4 * v;
                        w4n[v] = *(const LAS f32x4*)(rec + o); b4n[v] = *(const LAS f32x4*)(rec + 64 + o); kd4n[v] = *(const LAS f32x4*)(rec + 128 + o); kk4n[v] = *(const LAS f32x4*)(rec + 192 + o); wr4n[v] = *(const LAS f32x4*)(rec + 256 + o); }
                    vin = rec[320 + irow]; brn = rec[384]; c1n = rec[385]; }
                float p1 = 0.f, p2 = 0.f;
#pragma unroll
                for (int v = 0; v < NV; ++v) { p1 += s[v].x * kk4[v].x + s[v].y * kk4[v].y + s[v].z * kk4[v].z + s[v].w * kk4[v].w; p2 += s[v].x * wr4[v].x + s[v].y * wr4[v].y + s[v].z * wr4[v].z + s[v].w * wr4[v].w; }
                p1 = row_allreduce<LPR>(p1); p2 = row_allreduce<LPR>(p2);
                const float y = p2 - p1 * br + vi * c1;
#pragma unroll
                for (int v = 0; v < NV; ++v) s[v] = s[v] * w4[v] - p1 * b4[v] + vi * kd4[v];
                ybuf = (lr == (j & (LPR - 1))) ? y : ybuf;
                if ((j & (LPR - 1)) == LPR - 1) { const int step = sl * SLAB + (j - (LPR - 1)) + lr, t = d ? T - 1 - step : step;
                    O[(size_t)(base + t) * 512 + d * 256 + h * 64 + irow] = f2bf(ybuf); }
            }
        };
        if (wid >= 4) { issue(0, ra); finish(0, ra); issue(1, ra); }
        __syncthreads();
        if (wid < 4) __builtin_amdgcn_s_setprio(3);
        for (int sl = 0; sl < nslab; ++sl) {
            if (wid >= 4) { if (sl + 1 < nslab) finish(sl + 1, ra); if (sl + 2 < nslab) issue(sl + 2, ra); } else consume(sl);
            __syncthreads();
        }
        if (wid < 4) __builtin_amdgcn_s_setprio(0);
        if (wid < 4 && !lat) {
#pragma unroll
            for (int v = 0; v < NV; ++v) *(f32x4*)(p.out + OS_RWKV + ((size_t)(((b * 2 + l) * 2 + d) * 4 + h) * 64 + irow) * 64 + lr * EPL + 4 * v) = s[v]; }
    }
}

__device__ __forceinline__ void conv8_silu(const u32x4 pv, const u32x4 cv, const u32x4 nv, const float (&w)[32], float scale, u32x4& out) {
    float o[8];
#pragma unroll
    for (int j = 0; j < 4; ++j) {
        o[2 * j] = siluf_(w[24 + 2 * j] + w[2 * j] * bflo(pv[j]) + w[8 + 2 * j] * bflo(cv[j]) + w[16 + 2 * j] * bflo(nv[j])) * scale;
        o[2 * j + 1] = siluf_(w[24 + 2 * j + 1] + w[2 * j + 1] * bfhi(pv[j]) + w[8 + 2 * j + 1] * bfhi(cv[j]) + w[16 + 2 * j + 1] * bfhi(nv[j])) * scale;
    }
    out.x = pk2(o[0], o[1]); out.y = pk2(o[2], o[3]); out.z = pk2(o[4], o[5]); out.w = pk2(o[6], o[7]);
}
__device__ __forceinline__ void prep_ssd(const Params& p, int l) {
    const int lane = otid() & 63, gw = blockIdx.x * 8 + __builtin_amdgcn_readfirstlane(otid() >> 6), nw = gridDim.x * 8;
    const bf16_t* U = (const bf16_t*)(p.ws + OFF_US);
    bf16_t* P = (bf16_t*)(p.ws + OFF_PS); float* DT = (float*)(p.ws + OFF_DT); const bf16_t* UD = (const bf16_t*)(p.ws + OFF_UD);
    const float* cw = p.in[14] + l * 3 * 768; const float* cb = p.in[15] + l * 768;
    float w[3][32]; int qk[3], ck[3];
#pragma unroll
    for (int k = 0; k < 3; ++k) { const int g = lane + 64 * k; qk[k] = g / 96; ck[k] = (g % 96) * 8;
#pragma unroll
        for (int j = 0; j < 8; ++j) { w[k][j] = cw[ck[k] + j]; w[k][8 + j] = cw[768 + ck[k] + j]; w[k][16 + j] = cw[1536 + ck[k] + j]; w[k][24 + j] = cb[ck[k] + j]; } }
    const float dtb = lane < 16 ? p.in[16][l * 16 + lane] : 0.f, na = lane < 16 ? -__expf(p.in[17][l * 16 + lane]) : 0.f;
    u32x4 cvn[3], pvn[3], nvn[3]; float rawn[2];
    auto load_rows = [&](int r0) {
#pragma unroll
        for (int k = 0; k < 3; ++k) { const int r = r0 + qk[k] * nw < MT ? r0 + qk[k] * nw : r0;
            int t, T; if (r < NCTX) { t = r & 255; T = 256; } else { t = (r - NCTX) & 4095; T = 4096; }
            const bf16_t* ur = U + (size_t)r * 768 + ck[k];
            cvn[k] = *(const u32x4*)ur; pvn[k] = *(const u32x4*)(ur - (t > 0 ? 768 : 0)); nvn[k] = *(const u32x4*)(ur + (t < T - 1 ? 768 : 0));
            if (t == 0) pvn[k] = (u32x4){0u, 0u, 0u, 0u}; if (t == T - 1) nvn[k] = (u32x4){0u, 0u, 0u, 0u}; }
#pragma unroll
        for (int q = 0; q < 2; ++q) { const int r = r0 + q * nw < MT ? r0 + q * nw : r0; rawn[q] = lane < 16 ? bf2f(UD[(size_t)r * 256 + lane]) : 0.f; }
    };
    if (gw < MT) load_rows(gw);
    for (int r0 = gw; r0 < MT; r0 += 2 * nw) {
        u32x4 cv[3], pv[3], nv[3]; float raw[2]; int rr[3];
#pragma unroll
        for (int k = 0; k < 3; ++k) { cv[k] = cvn[k]; pv[k] = pvn[k]; nv[k] = nvn[k]; rr[k] = r0 + qk[k] * nw < MT ? r0 + qk[k] * nw : r0; }
        raw[0] = rawn[0]; raw[1] = rawn[1];
        if (r0 + 2 * nw < MT) load_rows(r0 + 2 * nw);
#pragma unroll
        for (int k = 0; k < 3; ++k) { if (r0 + qk[k] * nw >= MT) continue; u32x4 o; conv8_silu(pv[k], cv[k], nv[k], w[k], 1.f, o); *(u32x4*)(P + (size_t)rr[k] * 768 + ck[k]) = o; }
#pragma unroll
        for (int q = 0; q < 2; ++q) { const int r = r0 + q * nw; if (r >= MT) break;
            if (lane < 16) { const float dt = softplusf_(raw[q] + dtb); DT[(size_t)r * 32 + lane] = dt; DT[(size_t)r * 32 + 16 + lane] = dt * na; } }
    }
}
__device__ __forceinline__ void prep_mlstm(const Params& p, int l) {
    const int lane = otid() & 63, gw = blockIdx.x * 8 + __builtin_amdgcn_readfirstlane(otid() >> 6), nw = gridDim.x * 8;
    const bf16_t* U = (const bf16_t*)(p.ws + OFF_UM);
    bf16_t* P = (bf16_t*)(p.ws + OFF_PM); float* GM = (float*)(p.ws + OFF_GM); const bf16_t* UD = (const bf16_t*)(p.ws + OFF_UD);
    const float* cw = p.in[30] + l * 3 * 512; const float* cb = p.in[31] + l * 512;
    float w[32]; const int ck = lane * 8;
#pragma unroll
    for (int j = 0; j < 8; ++j) { w[j] = cw[ck + j]; w[8 + j] = cw[512 + ck + j]; w[16 + j] = cw[1024 + ck + j]; w[24 + j] = cb[ck + j]; }
    const float scale = ck >= 256 ? 0.125f : 1.f;
    float gb = 0.f; { const int d = lane >> 3, gi = (lane >> 2) & 1, hh = lane & 3; if (lane < 16) gb = gi == 0 ? p.in[32][(l * 2 + d) * 4 + hh] : p.in[33][(l * 2 + d) * 4 + hh]; }
    u32x4 cvn[2], pvn[2], nvn[2]; float rawn[2];
    auto load_rows = [&](int r0) {
#pragma unroll
        for (int q = 0; q < 2; ++q) { const int r = r0 + q * nw < MT ? r0 + q * nw : r0;
            int t, T; if (r < NCTX) { t = r & 255; T = 256; } else { t = (r - NCTX) & 4095; T = 4096; }
            const bf16_t* ur = U + (size_t)r * 512 + ck;
            cvn[q] = *(const u32x4*)ur; pvn[q] = *(const u32x4*)(ur - (t > 0 ? 512 : 0)); nvn[q] = *(const u32x4*)(ur + (t < T - 1 ? 512 : 0));
            if (t == 0) pvn[q] = (u32x4){0u, 0u, 0u, 0u}; if (t == T - 1) nvn[q] = (u32x4){0u, 0u, 0u, 0u};
            rawn[q] = lane < 16 ? bf2f(UD[(size_t)r * 256 + 16 + lane]) : 0.f; }
    };
    if (gw < MT) load_rows(gw);
    for (int r0 = gw; r0 < MT; r0 += 2 * nw) {
        u32x4 cv[2], pv[2], nv[2]; float raw[2];
#pragma unroll
        for (int q = 0; q < 2; ++q) { cv[q] = cvn[q]; pv[q] = pvn[q]; nv[q] = nvn[q]; raw[q] = rawn[q]; }
        if (r0 + 2 * nw < MT) load_rows(r0 + 2 * nw);
#pragma unroll
        for (int q = 0; q < 2; ++q) { const int r = r0 + q * nw; if (r >= MT) break;
            u32x4 o; conv8_silu(pv[q], cv[q], nv[q], w, scale, o); *(u32x4*)(P + (size_t)r * 768 + ck) = o;
            if (lane < 16) { const int d = lane >> 3, gi = (lane >> 2) & 1, hh = lane & 3;
                if (gi == 0) GM[(size_t)r * 16 + d * 8 + hh] = raw[q] + gb;
                else GM[(size_t)r * 16 + d * 8 + 4 + hh] = -softplusf_(-(raw[q] + gb)); } }
    }
}
typedef pg8::bf16x8 bf16x8;
constexpr int LDW = 72;
__device__ __forceinline__ bf16x8 ldfrag(const LAS bf16_t* b, int row, int k0) { return *(const LAS bf16x8*)(b + row * LDW + k0); }
__device__ __forceinline__ f32x4 mma(bf16x8 a, bf16x8 b, f32x4 c) { return __builtin_amdgcn_mfma_f32_16x16x32_bf16(a, b, c, 0, 0, 0); }
template <int CTRL> __device__ __forceinline__ float dppmov_old(float old, float x) { return __int_as_float(__builtin_amdgcn_update_dpp(__float_as_int(old), __float_as_int(x), CTRL, 0xF, 0xF, false)); }
__device__ __forceinline__ float wave_prefix_sum(float x, int lane) {
    x += dppmov_old<0x111>(0.f, x); x += dppmov_old<0x112>(0.f, x); x += dppmov_old<0x114>(0.f, x); x += dppmov_old<0x118>(0.f, x);
    const int xi = __float_as_int(x);
    const float t0 = __int_as_float(__builtin_amdgcn_readlane(xi, 15)), t1 = __int_as_float(__builtin_amdgcn_readlane(xi, 31)), t2 = __int_as_float(__builtin_amdgcn_readlane(xi, 47));
    const int rw = lane >> 4;
    return x + (rw == 0 ? 0.f : rw == 1 ? t0 : rw == 2 ? t0 + t1 : t0 + t1 + t2);
}
__device__ __forceinline__ float wave_prefix_max(float x, int lane) {
    const float ninf = -__builtin_inff();
    x = fmaxf(x, dppmov_old<0x111>(ninf, x)); x = fmaxf(x, dppmov_old<0x112>(ninf, x)); x = fmaxf(x, dppmov_old<0x114>(ninf, x)); x = fmaxf(x, dppmov_old<0x118>(ninf, x));
    const int xi = __float_as_int(x);
    const float t0 = __int_as_float(__builtin_amdgcn_readlane(xi, 15)), t1 = __int_as_float(__builtin_amdgcn_readlane(xi, 31)), t2 = __int_as_float(__builtin_amdgcn_readlane(xi, 47));
    const int rw = lane >> 4;
    return fmaxf(x, rw == 0 ? ninf : rw == 1 ? t0 : rw == 2 ? fmaxf(t0, t1) : fmaxf(fmaxf(t0, t1), t2));
}
template <int MODE> __device__ __forceinline__ void scan_chunked(const Params& p, int l, LAS unsigned char* lds, int lb0, int nlb, int cb0, int ncb) {
    constexpr int NPT = MODE ? 5 : 4, NH = MODE ? 4 : 8, NLONG = 8 * NH * 2, NCTXI = 32 * NH * 2;
    constexpr int SZ_T = 64 * LDW, SZ_V = 80 * LDW;
    const int tid = otid(), wid = __builtin_amdgcn_readfirstlane(tid >> 6), lane = tid & 63, fr = lane & 15, fq = lane >> 4;
    LAS bf16_t* Qb = (LAS bf16_t*)lds;
    LAS bf16_t* Kb = Qb + 2 * SZ_T;
    LAS bf16_t* KT = Kb + 2 * SZ_T;
    LAS bf16_t* VT = KT + 2 * SZ_T;
    LAS bf16_t* Sb = VT + 2 * SZ_V;
    LAS bf16_t* Wm = Sb + 2 * SZ_V;
    LAS float* sc = (LAS float*)(Wm + SZ_T);
    LAS float* eALp = sc + 2 * 5 * 64;
    LAS float* den = eALp + 4;
    const bf16_t* PS = (const bf16_t*)(p.ws + OFF_PS); const float* DT = (const float*)(p.ws + OFF_DT);
    const bf16_t* PM = (const bf16_t*)(p.ws + OFF_PM); const float* GM = (const float*)(p.ws + OFF_GM);
    bf16_t* O = (bf16_t*)(p.ws + (MODE ? OFF_OM : OFF_OS));
    const int tau_s = tid & 63, c8 = wid;
    for (int pass = 0; pass < 2; ++pass) {
        const int b0 = pass == 0 ? lb0 : cb0, nbk = pass == 0 ? nlb : ncb, itn = pass == 0 ? NLONG : NCTXI;
        if ((int)blockIdx.x < b0 || (int)blockIdx.x >= b0 + nbk) continue;
        for (int u = blockIdx.x - b0; u < itn; u += nbk) {
            const bool lat = pass == 0;
            const int d = u & 1, h = (u >> 1) & (NH - 1), b = u / (2 * NH), g = h >> 2;
            const int base = lat ? NCTX + b * 4096 : b * 256, T = lat ? 4096 : 256, NC = T / 64;
            const int sidx = ((b * 2 + l) * 2 + d) * NH + h;
            const float dsk = (MODE == 0 && d == 0) ? p.in[18][l * 8 + h] : 0.f;
            f32x4 st[2], stn = {0.f, 0.f, 0.f, 0.f};
            float m0 = 0.f;
            {
                const float* s0 = MODE ? p.in[4] : p.in[2];
#pragma unroll
                for (int e = 0; e < 2; ++e) { const int pt = wid >> 1, nt = (wid & 1) * 2 + e;
#pragma unroll
                    for (int i = 0; i < 4; ++i) { const int pp = pt * 16 + fq * 4 + i, nn = nt * 16 + fr;
                        st[e][i] = lat ? s0[((size_t)sidx * 64 + pp) * 64 + nn] : 0.f;
                        Sb[pp * LDW + nn] = f2bf(st[e][i]); } }
                if (MODE && wid >= 4) { const int nn = (wid - 4) * 16 + fr;
                    if (lat && fq == 0) stn[0] = p.in[5][(size_t)sidx * 64 + nn];
#pragma unroll
                    for (int i = 0; i < 4; ++i) Sb[(64 + fq * 4 + i) * LDW + nn] = f2bf(stn[i]); }
                if (MODE && lat) m0 = p.in[6][sidx];
                for (int i = tid; i < 64 * LDW; i += 512) Wm[i] = (bf16_t)0;
                if (MODE) { for (int i = tid; i < 2 * 16 * 64; i += 512) { const int bsel = i >> 10, rr = (i >> 6) & 15, cc = i & 63; VT[bsel * SZ_V + (64 + rr) * LDW + cc] = rr == 0 ? (bf16_t)0x3F80 : (bf16_t)0; } }
            }
            u32x4 rq, rk, rv;
            auto tok = [&](int c, int tau) { const int step = c * 64 + tau; return base + (d ? T - 1 - step : step); };
            auto load_regs = [&](int c) {
                const size_t row = (size_t)tok(c, tau_s);
                if (MODE == 0) { const bf16_t* pr = PS + row * 768; rq = *(const u32x4*)(pr + 640 + g * 64 + c8 * 8); rk = *(const u32x4*)(pr + 512 + g * 64 + c8 * 8); rv = *(const u32x4*)(pr + h * 64 + c8 * 8); }
                else { const bf16_t* pr = PM + row * 768; rq = *(const u32x4*)(pr + h * 64 + c8 * 8); rk = *(const u32x4*)(pr + 256 + h * 64 + c8 * 8); rv = *(const u32x4*)(pr + 512 + h * 64 + c8 * 8); }
            };
            float sr0 = 0.f, sr1 = 0.f;
            auto load_scal = [&](int c) {
                const size_t row = (size_t)tok(c, lane);
                if (MODE == 0) { sr0 = DT[row * 32 + d * 8 + h]; sr1 = DT[row * 32 + 16 + d * 8 + h]; }
                else { sr0 = GM[row * 16 + d * 8 + h]; sr1 = GM[row * 16 + d * 8 + 4 + h]; }
            };
            auto scalars = [&](int c) {
                const int Y = c & 1; LAS float* s_ = sc + Y * 320;
                float A, beta, emm = 0.f;
                if (MODE == 0) { A = wave_prefix_sum(sr1, lane); beta = sr0; }
                else { const float ig = sr0, lf = sr1;
                    const float F = wave_prefix_sum(lf, lane), pm = wave_prefix_max(ig - F, lane), mx = fmaxf(m0, pm), mt = F + mx;
                    A = m0 - mx; beta = __expf(ig - mt); emm = __expf(-mt);
                    m0 = __int_as_float(__builtin_amdgcn_readlane(__float_as_int(mt), 63)); }
                const float AL = __int_as_float(__builtin_amdgcn_readlane(__float_as_int(A), 63));
                s_[lane] = A; s_[64 + lane] = __expf(A); s_[128 + lane] = beta; s_[192 + lane] = __expf(AL - A) * beta; s_[256 + lane] = emm;
                if (lane == 0) eALp[Y] = __expf(AL);
            };
            auto store_regs = [&](int c) {
                const int Y = c & 1;
                *(LAS u32x4*)(Qb + Y * SZ_T + tau_s * LDW + c8 * 8) = rq;
                *(LAS u32x4*)(Kb + Y * SZ_T + tau_s * LDW + c8 * 8) = rk;
                const float w = sc[Y * 320 + 192 + tau_s];
#pragma unroll
                for (int j = 0; j < 4; ++j) {
                    KT[Y * SZ_T + (c8 * 8 + 2 * j) * LDW + tau_s] = f2bf(bflo(rk[j]) * w); KT[Y * SZ_T + (c8 * 8 + 2 * j + 1) * LDW + tau_s] = f2bf(bfhi(rk[j]) * w);
                    VT[Y * SZ_V + (c8 * 8 + 2 * j) * LDW + tau_s] = (bf16_t)(rv[j] & 0xffff); VT[Y * SZ_V + (c8 * 8 + 2 * j + 1) * LDW + tau_s] = (bf16_t)(rv[j] >> 16);
                }
            };
            load_regs(0);
            if (wid == 0) { load_scal(0); scalars(0); if (NC > 1) load_scal(1); }
            __syncthreads();
            store_regs(0);
            __syncthreads();
            for (int c = 0; c < NC; ++c) {
                const int X = c & 1, Y = X ^ 1;
                const LAS bf16_t* Qx = Qb + X * SZ_T; const LAS bf16_t* Kx = Kb + X * SZ_T; const LAS bf16_t* KTx = KT + X * SZ_T; const LAS bf16_t* VTx = VT + X * SZ_V; const LAS bf16_t* Sx = Sb + X * SZ_V;
                const LAS float* sx = sc + X * 320;
                if (c + 1 < NC) { load_regs(c + 1); if (wid == 0) { scalars(c + 1); if (c + 2 < NC) load_scal(c + 2); } }
                const int tt = wid >> 1;
                const bf16x8 aq0 = ldfrag(Qx, tt * 16 + fr, fq * 8), aq1 = ldfrag(Qx, tt * 16 + fr, 32 + fq * 8);
#pragma unroll
                for (int e = 0; e < 2; ++e) { const int ts = (wid & 1) * 2 + e;
                    if (ts > tt) continue;
                    f32x4 gacc = {0.f, 0.f, 0.f, 0.f};
                    gacc = mma(aq0, ldfrag(Kx, ts * 16 + fr, fq * 8), gacc); gacc = mma(aq1, ldfrag(Kx, ts * 16 + fr, 32 + fq * 8), gacc);
                    const int s_ = ts * 16 + fr; const float As = sx[s_], bs = sx[128 + s_];
                    const bool diag = ts == tt;
#pragma unroll
                    for (int i = 0; i < 4; ++i) { const int t = tt * 16 + fq * 4 + i; const float v = (diag && s_ > t) ? 0.f : gacc[i] * __expf(sx[t] - As) * bs; Wm[t * LDW + s_] = f2bf(v); } }
                __syncthreads();
                const float eAL = eALp[X];
                float dn[4] = {1.f, 1.f, 1.f, 1.f};
                if (MODE) {
                    f32x4 intra = {0.f, 0.f, 0.f, 0.f}, inter = {0.f, 0.f, 0.f, 0.f};
                    intra = mma(ldfrag(Wm, tt * 16 + fr, fq * 8), ldfrag(VTx, 64 + fr, fq * 8), intra);
                    if (tt >= 2) intra = mma(ldfrag(Wm, tt * 16 + fr, 32 + fq * 8), ldfrag(VTx, 64 + fr, 32 + fq * 8), intra);
                    inter = mma(aq0, ldfrag(Sx, 64 + fr, fq * 8), inter); inter = mma(aq1, ldfrag(Sx, 64 + fr, 32 + fq * 8), inter);
#pragma unroll
                    for (int i = 0; i < 4; ++i) { const int t = tt * 16 + fq * 4 + i; const float dv = intra[i] + sx[64 + t] * inter[i];
                        dn[i] = rcpf_(fmaxf(fabsf(__shfl(dv, lane & 48)), sx[256 + t])); }
                    if (wid >= 4) { const int nt = wid - 4;
                        stn = stn * eAL;
                        stn = mma(ldfrag(VTx, 64 + fr, fq * 8), ldfrag(KTx, nt * 16 + fr, fq * 8), stn); stn = mma(ldfrag(VTx, 64 + fr, 32 + fq * 8), ldfrag(KTx, nt * 16 + fr, 32 + fq * 8), stn);
#pragma unroll
                        for (int i = 0; i < 4; ++i) Sb[Y * SZ_V + (64 + fq * 4 + i) * LDW + nt * 16 + fr] = f2bf(stn[i]); }
                }
#pragma unroll
                for (int e = 0; e < 2; ++e) { const int pt = wid >> 1, nt = (wid & 1) * 2 + e;
                    st[e] = st[e] * eAL;
                    st[e] = mma(ldfrag(VTx, pt * 16 + fr, fq * 8), ldfrag(KTx, nt * 16 + fr, fq * 8), st[e]); st[e] = mma(ldfrag(VTx, pt * 16 + fr, 32 + fq * 8), ldfrag(KTx, nt * 16 + fr, 32 + fq * 8), st[e]);
#pragma unroll
                    for (int i = 0; i < 4; ++i) Sb[Y * SZ_V + (pt * 16 + fq * 4 + i) * LDW + nt * 16 + fr] = f2bf(st[e][i]); }
                if (c + 1 < NC) store_regs(c + 1);
                {
                    const bf16x8 aw0 = ldfrag(Wm, tt * 16 + fr, fq * 8), aw1 = ldfrag(Wm, tt * 16 + fr, 32 + fq * 8);
                    constexpr int OST = MODE ? 512 : 1024;
                    bf16_t* ob = O + (size_t)tok(c, tt * 16 + fq * 4) * OST + d * (MODE ? 256 : 512) + h * 64 + fr; const int osi = d ? -OST : OST;
#pragma unroll
                    for (int e = 0; e < 2; ++e) { const int pt = (wid & 1) * 2 + e;
                        f32x4 intra = {0.f, 0.f, 0.f, 0.f}, inter = {0.f, 0.f, 0.f, 0.f};
                        intra = mma(aw0, ldfrag(VTx, pt * 16 + fr, fq * 8), intra);
                        if (tt >= 2) intra = mma(aw1, ldfrag(VTx, pt * 16 + fr, 32 + fq * 8), intra);
                        inter = mma(aq0, ldfrag(Sx, pt * 16 + fr, fq * 8), inter); inter = mma(aq1, ldfrag(Sx, pt * 16 + fr, 32 + fq * 8), inter);
                        const int pp = pt * 16 + fr;
#pragma unroll
                        for (int i = 0; i < 4; ++i) { const int t = tt * 16 + fq * 4 + i;
                            float o = intra[i] + sx[64 + t] * inter[i];
                            if (MODE == 0) { if (d == 0) o += dsk * bf2f(VTx[pp * LDW + t]); }
                            else o *= dn[i];
                            ob[i * osi + pt * 16] = f2bf(o); } }
                }
                __syncthreads();
            }
            if (!lat) {
                float* so = p.out + (MODE ? OS_MC : OS_SSD);
#pragma unroll
                for (int e = 0; e < 2; ++e) { const int pt = wid >> 1, nt = (wid & 1) * 2 + e;
#pragma unroll
                    for (int i = 0; i < 4; ++i) so[((size_t)sidx * 64 + pt * 16 + fq * 4 + i) * 64 + nt * 16 + fr] = st[e][i]; }
                if (MODE && wid >= 4 && fq == 0) p.out[OS_MN + (size_t)sidx * 64 + (wid - 4) * 16 + fr] = stn[0];
                if (MODE && tid == 0) p.out[OS_MM + sidx] = m0;
            }
        }
    }
}

__device__ __forceinline__ void post_phase(const Params& p, int l) {
    const int lane = otid() & 63, gw = blockIdx.x * 8 + __builtin_amdgcn_readfirstlane(otid() >> 6), nw = gridDim.x * 8;
    const bf16_t* OS = (const bf16_t*)(p.ws + OFF_OS); const bf16_t* ZS = (const bf16_t*)(p.ws + OFF_ZS);
    const bf16_t* OR_ = (const bf16_t*)(p.ws + OFF_OR); const bf16_t* GR = (const bf16_t*)(p.ws + OFF_GR);
    const bf16_t* OM = (const bf16_t*)(p.ws + OFF_OM); const bf16_t* OG = (const bf16_t*)(p.ws + OFF_OG);
    bf16_t* Y = (bf16_t*)(p.ws + OFF_H);
    const float* gs = p.in[19] + l * 512; const float* gr = p.in[29] + l * 256; const float* gm = p.in[34] + l * 256;
    float gsv[8], ggv2[2][4];
#pragma unroll
    for (int j = 0; j < 8; ++j) gsv[j] = gs[lane * 8 + j];
#pragma unroll
    for (int j = 0; j < 4; ++j) { ggv2[0][j] = gr[lane * 4 + j]; ggv2[1][j] = gm[lane * 4 + j]; }
    u32x4 yfn[2], ybn[2], zzn[2]; u32x2 ofn[2][2], obn[2][2], gxn[2][2];
    auto load_rows = [&](int r0) {
#pragma unroll
        for (int q = 0; q < 2; ++q) { const size_t r = r0 + q * nw < MT ? r0 + q * nw : r0;
            yfn[q] = *(const u32x4*)(OS + r * 1024 + lane * 8); ybn[q] = *(const u32x4*)(OS + r * 1024 + 512 + lane * 8); zzn[q] = *(const u32x4*)(ZS + r * 512 + lane * 8);
            ofn[q][0] = *(const u32x2*)(OR_ + r * 512 + lane * 4); obn[q][0] = *(const u32x2*)(OR_ + r * 512 + 256 + lane * 4); gxn[q][0] = *(const u32x2*)(GR + r * 256 + lane * 4);
            ofn[q][1] = *(const u32x2*)(OM + r * 512 + lane * 4); obn[q][1] = *(const u32x2*)(OM + r * 512 + 256 + lane * 4); gxn[q][1] = *(const u32x2*)(OG + r * 256 + lane * 4); }
    };
    if (gw < MT) load_rows(gw);
    for (int r0 = gw; r0 < MT; r0 += 2 * nw) {
        u32x4 yf[2], yb[2], zz[2]; u32x2 of[2][2], ob[2][2], gx[2][2];
#pragma unroll
        for (int q = 0; q < 2; ++q) { yf[q] = yfn[q]; yb[q] = ybn[q]; zz[q] = zzn[q];
#pragma unroll
            for (int m = 0; m < 2; ++m) { of[q][m] = ofn[q][m]; ob[q][m] = obn[q][m]; gx[q][m] = gxn[q][m]; } }
        if (r0 + 2 * nw < MT) load_rows(r0 + 2 * nw);
#pragma unroll
        for (int q = 0; q < 2; ++q) { const size_t r = r0 + q * nw; if (r >= (size_t)MT) break;
            {
                const int c = lane * 8;
                float y[8];
#pragma unroll
                for (int j = 0; j < 4; ++j) { y[2 * j] = (bflo(yf[q][j]) + bflo(yb[q][j])) * bflo(zz[q][j]); y[2 * j + 1] = (bfhi(yf[q][j]) + bfhi(yb[q][j])) * bfhi(zz[q][j]); }
                float ss = 0.f;
#pragma unroll
                for (int j = 0; j < 8; ++j) ss += y[j] * y[j];
#pragma unroll
                for (int o = 1; o < 32; o <<= 1) ss += __shfl_xor(ss, o);
                const float rstd = rsqrtf(ss * (1.f / 256.f) + 1e-5f);
                u32x4 w;
#pragma unroll
                for (int j = 0; j < 4; ++j) w[j] = pk2(y[2 * j] * rstd * gsv[2 * j], y[2 * j + 1] * rstd * gsv[2 * j + 1]);
                *(u32x4*)(Y + r * 1024 + c) = w;
            }
#pragma unroll
            for (int mx = 0; mx < 2; ++mx) {
                const int c = lane * 4;
                float v[4] = {bflo(of[q][mx].x) + bflo(ob[q][mx].x), bfhi(of[q][mx].x) + bfhi(ob[q][mx].x), bflo(of[q][mx].y) + bflo(ob[q][mx].y), bfhi(of[q][mx].y) + bfhi(ob[q][mx].y)};
                float sm_ = v[0] + v[1] + v[2] + v[3];
                sm_ = row_allreduce<16>(sm_);
                const float mean = sm_ * (1.f / 64.f);
                float ss = 0.f;
#pragma unroll
                for (int j = 0; j < 4; ++j) { v[j] -= mean; ss += v[j] * v[j]; }
                ss = row_allreduce<16>(ss);
                const float rstd = rsqrtf(ss * (1.f / 64.f) + 1e-5f);
                const float* gg = mx == 0 ? gr : gm;
                float gt[4] = {bflo(gx[q][mx].x), bfhi(gx[q][mx].x), bflo(gx[q][mx].y), bfhi(gx[q][mx].y)};
                u32x2 w; w.x = pk2(v[0] * rstd * ggv2[mx][0] * gt[0], v[1] * rstd * ggv2[mx][1] * gt[1]); w.y = pk2(v[2] * rstd * ggv2[mx][2] * gt[2], v[3] * rstd * ggv2[mx][3] * gt[3]);
                *(u32x2*)(Y + r * 1024 + 512 + mx * 256 + c) = w;
            }
        }
    }
}

constexpr int NSUB = 12, NPHASE = 2 + 2 * NSUB;
__device__ __forceinline__ void run_phase(const Params& p, int ph, unsigned char* shm) {
    LAS unsigned char* lds = (LAS unsigned char*)shm;
    if (ph == 0) { prologue_phase(p, (float*)shm); return; }
    if (ph == NPHASE - 1) { norm_phase(p, 0, 2, 0, MT, (const bf16_t*)(p.ws + OFF_H)); return; }
    const int l = (ph - 1) / NSUB, sub = (ph - 1) % NSUB;
    const bf16_t* H = (const bf16_t*)(p.ws + OFF_H);
    const float* modl = (const float*)(p.ws + OFF_MOD) + (size_t)l * 9 * 6144;
    switch (sub) {
    case 0: norm_phase(p, l, 0); break;
    case 1: { EpiStoreBf16 E{(bf16_t*)(p.ws + OFF_UR), NR}; run_gemm(lds, H, (const bf16_t*)(p.ws + OFF_WR) + (size_t)l * NR * 1024, NR, 1024, E); } break;
    case 2: prep_rwkv(p, l, (float*)shm); break;
    case 3: scan_rwkv<16>(p, l, (LAS float*)lds); scan_rwkv<8>(p, l, (LAS float*)lds); break;
    case 4: { EpiSM E{EpiSSD{(bf16_t*)(p.ws + OFF_ZS), (bf16_t*)(p.ws + OFF_US), (bf16_t*)(p.ws + OFF_UD)}, EpiMLSTM{(bf16_t*)(p.ws + OFF_UM), (bf16_t*)(p.ws + OFF_PM), (bf16_t*)(p.ws + OFF_OG)}};
        run_gemm(lds, H, (const bf16_t*)(p.ws + OFF_WS) + (size_t)l * NSM * 1024, NSM, 1024, E); } break;
    case 5: prep_ssd(p, l); prep_mlstm(p, l); break;
    case 6: {
        const bool g256 = gridDim.x >= 256;
        scan_chunked<0>(p, l, lds, 0, g256 ? 128 : (int)gridDim.x, g256 ? 192 : 0, g256 ? (int)gridDim.x - 192 : (int)gridDim.x);
        scan_chunked<1>(p, l, lds, g256 ? 128 : 0, g256 ? 64 : (int)gridDim.x, g256 ? 192 : 0, g256 ? (int)gridDim.x - 192 : (int)gridDim.x); } break;
    case 7: post_phase(p, l); break;
    case 8: case 11: {
        const bool ffn = sub == 11;
        EpiResidual E{p.in[0], p.in[1], (!ffn && l == 0) ? 1 : 0, (bf16_t*)p.out, modl + (ffn ? 5120 : 2048), (ffn && l == 1) ? (bf16_t*)(p.ws + OFF_H) : (bf16_t*)p.out};
        const bf16_t* A = ffn ? (const bf16_t*)(p.ws + OFF_ACT) : H;
        const bf16_t* Bt = ffn ? (const bf16_t*)(p.ws + OFF_W2) + (size_t)l * 1024 * 2816 : (const bf16_t*)(p.ws + OFF_WO) + (size_t)l * 1024 * 1024;
        run_gemm(lds, A, Bt, 1024, ffn ? 2816 : 1024, E); } break;
    case 9: norm_phase(p, l, 1); break;
    case 10: { EpiSwiglu E{(bf16_t*)(p.ws + OFF_ACT)}; run_gemm(lds, H, (const bf16_t*)(p.ws + OFF_W13) + (size_t)l * 5632 * 1024, 5632, 1024, E); } break;
    }
}
__global__ __launch_bounds__(512, 2) void mega(Params p) {
    extern __shared__ __attribute__((aligned(16))) unsigned char shm[];
    cg::grid_group grid = cg::this_grid();
    volatile LAS unsigned* st = (volatile LAS unsigned*)((LAS unsigned char*)shm + 131072);
    XcdBarrier xb; xb.bar = (unsigned*)(p.ws + OFF_BAR); xb.x = 0; xb.st = st;
    if (p.ph_hi - p.ph_lo > 1) {
        if (threadIdx.x < 4) st[threadIdx.x] = 0u;
        __syncthreads();
        xb = xcd_barrier_post((unsigned*)(p.ws + OFF_BAR), st);
    }
    int nsync = 0;
    for (int ph = p.ph_lo; ph < p.ph_hi; ++ph) {
        int reps = 1;
#ifdef PROBE_MASK
        if (ph > 0 && ph < NPHASE - 1 && ((PROBE_MASK >> ((ph - 1) % NSUB)) & 1)) reps += PROBE_REPS;
#endif
#ifdef PROBE_P0
        if (ph == 0) reps += PROBE_P0;
#endif
        for (int rep = 0; rep < reps; ++rep) {
            if (ph > p.ph_lo || rep > 0) { if (p.ph_lo < 0) grid.sync(); else xcd_barrier(xb); ++nsync; }
            run_phase(p, ph, shm);
        }
#ifdef PROBE_EMPTY
        if (ph == 1) { for (int k = 0; k < PROBE_EMPTY; ++k) xcd_barrier(xb); }
#endif
    }
}
}

extern "C" void kernel_launch(void* const* d_in, const int* in_sizes, int n_in, void* d_out, int out_size, void* d_ws, size_t ws_size, hipStream_t stream) {
    static int grid = 0;
    if (grid == 0) {
        if (n_in != 40 || ws_size < mk::WS_END2) { fprintf(stderr, "kernel_launch: need 40 inputs and %zu bytes of workspace (got %d, %zu)\n", (size_t)mk::WS_END2, n_in, ws_size); grid = -1; return; }
        int dev = 0, cus = 0, per_cu = 0;
        hipGetDevice(&dev); hipDeviceGetAttribute(&cus, hipDeviceAttributeMultiprocessorCount, dev);
        if (hipFuncSetAttribute((const void*)mk::mega, hipFuncAttributeMaxDynamicSharedMemorySize, mk::LDS_BYTES) != hipSuccess) { fprintf(stderr, "kernel_launch: hipFuncSetAttribute failed\n"); }
        if (hipOccupancyMaxActiveBlocksPerMultiprocessor(&per_cu, (const void*)mk::mega, 512, mk::LDS_BYTES) != hipSuccess || per_cu < 1) per_cu = 1;
        (void)hipGetLastError();
        grid = cus * 1;
    }
    if (grid < 0) return;
    if (hipMemsetAsync((char*)d_ws + mk::OFF_BAR, 0, 16384, stream) != hipSuccess) { fprintf(stderr, "kernel_launch: memset of the barrier words failed\n"); return; }
    mk::Params p{};
    for (int i = 0; i < 40; ++i) p.in[i] = (const float*)d_in[i];
    p.out = (float*)d_out; p.ws = (unsigned char*)d_ws;
#if ONE_LAUNCH
    p.ph_lo = 0; p.ph_hi = mk::NPHASE;
    void* args[] = {&p};
    hipError_t e = hipLaunchCooperativeKernel((const void*)mk::mega, dim3(grid), dim3(512), args, mk::LDS_BYTES, stream);
    if (e != hipSuccess) fprintf(stderr, "cooperative launch failed: %s (grid %d)\n", hipGetErrorString(e), grid);
#else
    for (int ph = 0; ph < mk::NPHASE; ++ph) {
        p.ph_lo = ph; p.ph_hi = ph + 1;
        hipLaunchKernelGGL(mk::mega, dim3(grid), dim3(512), mk::LDS_BYTES, stream, p);
    }
#endif
}
```
